# Optimizing an MI355X kernel written in HIP

```python
import jax
import jax.numpy as jnp
from jax import lax
import numpy as np

D_MODEL = 1024
BATCH = 2
SEQ = 16384
DEPTH = 2

CTX_LEN = 256
GRID_W = 64
N_MIXERS = 4
MIX_WIDTH = D_MODEL
GROUP_WIDTH = MIX_WIDTH // N_MIXERS
GROUP_HEADS = 4
HEAD_DIM = GROUP_WIDTH // GROUP_HEADS
NA_ROWS = 8
NA_COLS = 16
ML_CHUNK = 64
ML_CONV = 5
MLA_Q_RANK = 256
MLA_KV_RANK = 128
MLA_NOPE = 64
MLA_ROPE = 32
MLA_V = 64
SWA_KV_HEADS = 2
SWA_WINDOW = 128
ATTN_BLOCK = 128
PEER_HEADS = 8
PEER_NKEYS = 128
PEER_EXPERTS = PEER_NKEYS * PEER_NKEYS
PEER_DKEY = 128
PEER_TOPK = 16
PEER_BLOCK = 128
ROPE_BASE = 10000.0
EPS = 1e-6
IN_SIZES = (GROUP_WIDTH, GROUP_WIDTH, GROUP_WIDTH,
            2 * GROUP_WIDTH, GROUP_WIDTH, GROUP_WIDTH, 4 * GROUP_HEADS,
            MLA_Q_RANK, MLA_KV_RANK, MLA_ROPE,
            GROUP_WIDTH, SWA_KV_HEADS * HEAD_DIM, SWA_KV_HEADS * HEAD_DIM)
IN_WIDTH = sum(IN_SIZES)
F32 = jnp.float32

kernel_name = 'hybrid_na_mlstm_mla_swa_peer_dit'


def rmsnorm(x, g):
    xf = x.astype(F32)
    y = xf * lax.rsqrt(jnp.mean(xf * xf, axis=-1, keepdims=True) + EPS) * g.astype(F32)
    return y.astype(x.dtype)


def heads(a, h):
    return a.reshape(a.shape[:-1] + (h, a.shape[-1] // h))


def split_cols(p):
    return jnp.split(p, np.cumsum(IN_SIZES)[:-1].tolist(), axis=-1)


def axial_angles(T, rot_dim):
    t = jnp.arange(T)
    row = (t // GRID_W).astype(F32)
    col = (t % GRID_W).astype(F32)
    half = rot_dim // 2
    inv = 1.0 / (ROPE_BASE ** (jnp.arange(0, half, 2, dtype=F32) / half))
    return row[:, None] * inv, col[:, None] * inv


def rope_1d(x, ang):
    cos = jnp.cos(ang)[None, :, None, :]
    sin = jnp.sin(ang)[None, :, None, :]
    x1, x2 = jnp.split(x.astype(F32), 2, axis=-1)
    return jnp.concatenate([x1 * cos - x2 * sin, x1 * sin + x2 * cos], axis=-1)


def rope_2d(x, angs):
    xr, xc = jnp.split(x, 2, axis=-1)
    return jnp.concatenate([rope_1d(xr, angs[0]), rope_1d(xc, angs[1])], axis=-1).astype(x.dtype)


def ctx_attn(q, k, v, scale, sink=None):
    rep = q.shape[2] // k.shape[2]
    k = jnp.repeat(k, rep, axis=2)
    v = jnp.repeat(v, rep, axis=2)
    s = jnp.einsum('bqhd,bkhd->bhqk', q, k).astype(F32) * scale
    nk = s.shape[-1]
    if sink is not None:
        s = jnp.concatenate([s, jnp.broadcast_to(sink.astype(F32)[None, :, None, None], s.shape[:-1] + (1,))], axis=-1)
    p = jax.nn.softmax(s, axis=-1)[..., :nk].astype(v.dtype)
    out = jnp.einsum('bhqk,bkhd->bqhd', p, v)
    return out.reshape(out.shape[:2] + (-1,))


def neighbourhood_attention(q, k, v, kc, vc, rpb):
    B, T, H, d = q.shape
    rows = T // GRID_W
    nr = min(NA_ROWS, rows)
    scale = d ** -0.5
    qg = jnp.swapaxes(q.reshape(B, rows, GRID_W, H, d), 0, 1)
    kg = k.reshape(B, rows, GRID_W, H, d)
    vg = v.reshape(B, rows, GRID_W, H, d)
    col_start = np.clip(np.arange(GRID_W) - NA_COLS // 2, 0, GRID_W - NA_COLS)
    col_idx = col_start[:, None] + np.arange(NA_COLS)[None, :]
    dc = col_idx - np.arange(GRID_W)[:, None] + (NA_COLS - 1)
    rpb_c = rpb.astype(F32)[:, :, dc]
    n_loc = nr * NA_COLS

    def row_block(args):
        qr, r = args
        rs = jnp.clip(r - nr // 2, 0, rows - nr)
        kr = lax.dynamic_slice_in_dim(kg, rs, nr, axis=1)[:, :, col_idx]
        vr = lax.dynamic_slice_in_dim(vg, rs, nr, axis=1)[:, :, col_idx]
        dr = rs + jnp.arange(nr) - r + (NA_ROWS - 1)
        bias = jnp.take(rpb_c, dr, axis=1)
        s_loc = jnp.einsum('bqhd,brqchd->bhqrc', qr, kr).astype(F32) * scale + jnp.transpose(bias, (0, 2, 1, 3))[None]
        s_ctx = jnp.einsum('bqhd,bkhd->bhqk', qr, kc).astype(F32) * scale
        p = jax.nn.softmax(jnp.concatenate([s_loc.reshape(B, H, GRID_W, n_loc), s_ctx], axis=-1), axis=-1).astype(v.dtype)
        p_loc = p[..., :n_loc].reshape(B, H, GRID_W, nr, NA_COLS)
        return (jnp.einsum('bhqrc,brqchd->bqhd', p_loc, vr)
                + jnp.einsum('bhqk,bkhd->bqhd', p[..., n_loc:], vc))

    out = lax.map(row_block, (qg, jnp.arange(rows)))
    return jnp.swapaxes(out, 0, 1).reshape(B, T, H * d)


def short_conv(a, w):
    T = a.shape[1]
    pad = w.shape[0] // 2
    ap = jnp.pad(a, ((0, 0), (pad, pad), (0, 0)))
    out = ap[:, :T] * w[0]
    for j in range(1, w.shape[0]):
        out = out + ap[:, j:j + T] * w[j]
    return out


def mlstm_scan(q, k, v, ig, lf, state):
    B, T, H, d = q.shape
    nc = T // ML_CHUNK

    def chunks(a):
        a = a.astype(F32).reshape((B, nc, ML_CHUNK) + a.shape[2:])
        return jnp.swapaxes(jnp.swapaxes(a, 0, 1), 2, 3)

    seen = jnp.tril(jnp.ones((ML_CHUNK, ML_CHUNK), dtype=bool))

    def step(carry, inp):
        C, n, m = carry
        qt, kt, vt, it, ft = inp
        b = jnp.cumsum(ft, axis=-1)
        d_log = jnp.where(seen, b[..., :, None] - b[..., None, :] + it[..., None, :], -jnp.inf)
        inter = b + m[..., None]
        m_t = jnp.maximum(inter, jnp.max(d_log, axis=-1))
        w = jnp.exp(d_log - m_t[..., None])
        a = jnp.exp(inter - m_t)
        s = jnp.einsum('bhtk,bhsk->bhts', qt, kt) * w
        num = jnp.einsum('bhts,bhsv->bhtv', s, vt) + a[..., None] * jnp.einsum('bhtk,bhkv->bhtv', qt, C)
        den = jnp.sum(s, axis=-1) + a * jnp.einsum('bhtk,bhk->bht', qt, n)
        h = num / jnp.maximum(jnp.abs(den), jnp.exp(-m_t))[..., None]
        g = b[..., -1:] - b + it
        m_new = jnp.maximum(b[..., -1] + m, jnp.max(g, axis=-1))
        wk = jnp.exp(g - m_new[..., None])
        decay = jnp.exp(b[..., -1] + m - m_new)
        C = decay[..., None, None] * C + jnp.einsum('bhs,bhsk,bhsv->bhkv', wk, kt, vt)
        n = decay[..., None] * n + jnp.einsum('bhs,bhsk->bhk', wk, kt)
        return (C, n, m_new), h

    state, h = lax.scan(step, state, (chunks(q), chunks(k), chunks(v), chunks(ig), chunks(lf)))
    h = jnp.swapaxes(jnp.swapaxes(h, 2, 3), 0, 1).reshape(B, T, H, d)
    return h.astype(v.dtype), state


def mlstm_prep(qk, v, gates, conv_w, gate_b):
    qk = jax.nn.silu(short_conv(qk, conv_w))
    q, k = jnp.split(qk, 2, axis=-1)
    g = (gates + gate_b).astype(F32)
    i_f, f_f, i_b, f_b = jnp.split(g, 4, axis=-1)
    return (heads(q, GROUP_HEADS) * HEAD_DIM ** -0.5, heads(k, GROUP_HEADS), heads(v, GROUP_HEADS),
            (i_f, jax.nn.log_sigmoid(f_f), i_b, jax.nn.log_sigmoid(f_b)))


def mlstm_mixer(lat, ctx, conv_w, gate_b):
    ql, kl, vl, gl = mlstm_prep(lat[0], lat[1], lat[2], conv_w, gate_b)
    qc, kc, vc, gc = mlstm_prep(ctx[0], ctx[1], ctx[2], conv_w, gate_b)
    B, _, H, d = ql.shape
    st0 = (jnp.zeros((B, H, d, d), F32), jnp.zeros((B, H, d), F32), jnp.zeros((B, H), F32))

    def rev(a):
        return a[:, ::-1]

    hc_f, st_f = mlstm_scan(qc, kc, vc, gc[0], gc[1], st0)
    hl_f, _ = mlstm_scan(ql, kl, vl, gl[0], gl[1], st_f)
    hc_b, st_b = mlstm_scan(rev(qc), rev(kc), rev(vc), rev(gc[2]), rev(gc[3]), st0)
    hl_b, _ = mlstm_scan(rev(ql), rev(kl), rev(vl), rev(gl[2]), rev(gl[3]), st_b)
    return hl_f + rev(hl_b), hc_f + rev(hc_b)


def mla_project(cq, ckv, kr, q_norm, w_uq, kv_norm, w_ukv, angs):
    q = heads(rmsnorm(cq, q_norm) @ w_uq, GROUP_HEADS)
    kv = heads(rmsnorm(ckv, kv_norm) @ w_ukv, GROUP_HEADS)
    q_nope, q_rope = q[..., :MLA_NOPE], q[..., MLA_NOPE:]
    k_nope, v = kv[..., :MLA_NOPE], kv[..., MLA_NOPE:]
    k_rope = kr[:, :, None, :]
    if angs is not None:
        q_rope = rope_2d(q_rope, angs)
        k_rope = rope_2d(k_rope, angs)
    k_rope = jnp.broadcast_to(k_rope, k_nope.shape[:-1] + (MLA_ROPE,))
    return (jnp.concatenate([q_nope, q_rope], axis=-1), jnp.concatenate([k_nope, k_rope], axis=-1), v)


def block_dense_attention(q, k_all, v_all, scale):
    B, T, H, dq = q.shape
    nb = T // ATTN_BLOCK
    qb = jnp.swapaxes(q.reshape(B, nb, ATTN_BLOCK, H, dq), 0, 1)

    def one(qblk):
        s = jnp.einsum('bqhd,bkhd->bhqk', qblk, k_all).astype(F32) * scale
        p = jax.nn.softmax(s, axis=-1).astype(v_all.dtype)
        return jnp.einsum('bhqk,bkhd->bqhd', p, v_all)

    out = lax.map(one, qb)
    return jnp.swapaxes(out, 0, 1).reshape(B, T, -1)


def window_attention(q, k, v, kc, vc, sink):
    B, T, H, d = q.shape
    KVH = k.shape[2]
    G = H // KVH
    nb = T // ATTN_BLOCK
    span = ATTN_BLOCK + 2 * SWA_WINDOW
    n_ctx = kc.shape[1]
    scale = d ** -0.5
    padw = ((0, 0), (SWA_WINDOW, SWA_WINDOW), (0, 0), (0, 0))
    kp = jnp.pad(k, padw)
    vp = jnp.pad(v, padw)
    start = jnp.arange(nb) * ATTN_BLOCK
    idx = start[:, None] + jnp.arange(span)[None, :]
    kb = kp[:, idx]
    vb = vp[:, idx]
    key_pos = idx - SWA_WINDOW
    q_pos = start[:, None] + jnp.arange(ATTN_BLOCK)[None, :]
    mask = ((jnp.abs(q_pos[:, :, None] - key_pos[:, None, :]) <= SWA_WINDOW)
            & (key_pos >= 0)[:, None, :] & (key_pos < T)[:, None, :])
    qb = q.reshape(B, nb, ATTN_BLOCK, KVH, G, d)
    s_loc = jnp.einsum('bnqhgd,bnkhd->bnhgqk', qb, kb).astype(F32) * scale
    s_loc = jnp.where(mask[None, :, None, None], s_loc, -jnp.inf)
    s_ctx = jnp.einsum('bnqhgd,bkhd->bnhgqk', qb, kc).astype(F32) * scale
    s_sink = jnp.broadcast_to(sink.astype(F32).reshape(1, 1, KVH, G, 1, 1), s_loc.shape[:-1] + (1,))
    p = jax.nn.softmax(jnp.concatenate([s_loc, s_ctx, s_sink], axis=-1), axis=-1).astype(v.dtype)
    out = (jnp.einsum('bnhgqk,bnkhd->bnqhgd', p[..., :span], vb)
           + jnp.einsum('bnhgqk,bkhd->bnqhgd', p[..., span:span + n_ctx], vc))
    return out.reshape(B, T, H * d)


def peer_ffn(h, wq, sub_keys, u, v):
    N, D = h.shape
    hb = h.reshape(N // PEER_BLOCK, PEER_BLOCK, D)

    def block(xb):
        qry = (xb @ wq).reshape(PEER_BLOCK, PEER_HEADS, 2, PEER_DKEY)
        s = jnp.einsum('thpk,hpnk->thpn', qry, sub_keys).astype(F32)
        sv, si = lax.top_k(s, PEER_TOPK)
        cand_s = (sv[:, :, 0, :, None] + sv[:, :, 1, None, :]).reshape(PEER_BLOCK, PEER_HEADS, PEER_TOPK * PEER_TOPK)
        cand_i = (si[:, :, 0, :, None] * PEER_NKEYS + si[:, :, 1, None, :]).reshape(PEER_BLOCK, PEER_HEADS, PEER_TOPK * PEER_TOPK)
        fs, fpos = lax.top_k(cand_s, PEER_TOPK)
        eidx = jnp.take_along_axis(cand_i, fpos, axis=-1)
        gate = jax.nn.softmax(fs, axis=-1)
        act = jax.nn.gelu(jnp.einsum('td,thkd->thk', xb, u[eidx]).astype(F32), approximate=False)
        w = (gate * act).astype(xb.dtype)
        return jnp.einsum('thk,thkd->td', w, v[eidx])

    return lax.map(block, hb).reshape(N, D)


def hybrid_layer(x, xc, c, c_ctx, need_ctx, angs_mla, angs_swa,
                 norm1_g, norm2_g, w_ada, b_ada, w_in, na_rpb, ml_conv, ml_gate_b,
                 mla_q_norm, mla_w_uq, mla_kv_norm, mla_w_ukv, swa_sink, w_out,
                 peer_wq, peer_keys, peer_u, peer_v):
    B, T, D = x.shape
    H = GROUP_HEADS
    sh1, sc1, g1, sh2, sc2, g2 = jnp.split((jax.nn.silu(c) @ w_ada + b_ada)[:, None, :], 6, axis=-1)
    sh1c, sc1c, g1c, sh2c, sc2c, g2c = jnp.split(jax.nn.silu(c_ctx) @ w_ada + b_ada, 6, axis=-1)
    h = rmsnorm(x, norm1_g) * (1.0 + sc1) + sh1
    hc = rmsnorm(xc, norm1_g) * (1.0 + sc1c) + sh1c
    (na_q, na_k, na_v, ml_qk, ml_v, ml_o, ml_g,
     mla_cq, mla_ckv, mla_kr, sw_q, sw_k, sw_v) = split_cols(h @ w_in)
    (na_qc, na_kc, na_vc, ml_qkc, ml_vc, ml_oc, ml_gc,
     mla_cqc, mla_ckvc, mla_krc, sw_qc, sw_kc, sw_vc) = split_cols(hc @ w_in)
    attn_scale = HEAD_DIM ** -0.5
    mla_scale = (MLA_NOPE + MLA_ROPE) ** -0.5
    kc_a, vc_a = heads(na_kc, H), heads(na_vc, H)
    y_a = neighbourhood_attention(heads(na_q, H), heads(na_k, H), heads(na_v, H), kc_a, vc_a, na_rpb)
    h_lat, h_ctx = mlstm_mixer((ml_qk, ml_v, ml_g), (ml_qkc, ml_vc, ml_gc), ml_conv, ml_gate_b)
    y_b = h_lat.reshape(B, T, GROUP_WIDTH) * jax.nn.sigmoid(ml_o)
    q_m, k_m, v_m = mla_project(mla_cq, mla_ckv, mla_kr, mla_q_norm, mla_w_uq, mla_kv_norm, mla_w_ukv, angs_mla)
    qc_m, kc_m, vc_m = mla_project(mla_cqc, mla_ckvc, mla_krc, mla_q_norm, mla_w_uq, mla_kv_norm, mla_w_ukv, None)
    y_c = block_dense_attention(q_m, jnp.concatenate([kc_m, k_m], axis=1), jnp.concatenate([vc_m, v_m], axis=1), mla_scale)
    kc_d, vc_d = heads(sw_kc, SWA_KV_HEADS), heads(sw_vc, SWA_KV_HEADS)
    y_d = window_attention(rope_2d(heads(sw_q, H), angs_swa), rope_2d(heads(sw_k, SWA_KV_HEADS), angs_swa),
                           heads(sw_v, SWA_KV_HEADS), kc_d, vc_d, swa_sink)
    x = x + g1 * (jnp.concatenate([y_a, y_b, y_c, y_d], axis=-1) @ w_out)
    h2 = rmsnorm(x, norm2_g) * (1.0 + sc2) + sh2
    if need_ctx:
        Tc = xc.shape[1]
        y_ctx = jnp.concatenate([
            ctx_attn(heads(na_qc, H), kc_a, vc_a, attn_scale),
            h_ctx.reshape(B, Tc, GROUP_WIDTH) * jax.nn.sigmoid(ml_oc),
            ctx_attn(qc_m, kc_m, vc_m, mla_scale),
            ctx_attn(heads(sw_qc, H), kc_d, vc_d, attn_scale, swa_sink)], axis=-1)
        xc = xc + g1c * (y_ctx @ w_out)
        h2c = rmsnorm(xc, norm2_g) * (1.0 + sc2c) + sh2c
        f = peer_ffn(jnp.concatenate([h2.reshape(B * T, D), h2c.reshape(B * Tc, D)], axis=0),
                     peer_wq, peer_keys, peer_u, peer_v)
        x = x + g2 * f[:B * T].reshape(B, T, D)
        xc = xc + g2c * f[B * T:].reshape(B, Tc, D)
        return x, xc
    x = x + g2 * peer_ffn(h2.reshape(B * T, D), peer_wq, peer_keys, peer_u, peer_v).reshape(B, T, D)
    return x, None


def setup_inputs(seed: int = 0) -> dict:
    key = jax.random.key(seed)
    ks = iter(jax.random.split(key, 32))

    def nrm(shape, std):
        return jax.random.normal(next(ks), shape, F32) * std

    L, D, H = DEPTH, D_MODEL, GROUP_HEADS
    f_base = jnp.linspace(3.0, 6.0, H, dtype=F32)
    zero_h = jnp.zeros((H,), F32)
    gate_base = jnp.stack([zero_h, f_base, zero_h, f_base])
    return {
        'x': nrm((BATCH, SEQ, D), 1.0),
        'c': nrm((BATCH, D), 1.0),
        'ctx': nrm((BATCH, CTX_LEN, D), 1.0),
        'c_ctx': nrm((D,), 1.0),
        'norm1_g': 1.0 + nrm((L, D), 0.02),
        'norm2_g': 1.0 + nrm((L, D), 0.02),
        'w_ada': nrm((L, D, 6 * D), 0.5 * D ** -0.5),
        'b_ada': nrm((L, 6 * D), 0.02),
        'w_in': nrm((L, D, IN_WIDTH), D ** -0.5),
        'na_rpb': nrm((L, H, 2 * NA_ROWS - 1, 2 * NA_COLS - 1), 0.5),
        'ml_conv': nrm((L, ML_CONV, 2 * GROUP_WIDTH), ML_CONV ** -0.5),
        'ml_gate_b': (gate_base[None] + nrm((L, 4, H), 0.1)).reshape(L, 4 * H),
        'mla_q_norm': 1.0 + nrm((L, MLA_Q_RANK), 0.02),
        'mla_w_uq': nrm((L, MLA_Q_RANK, H * (MLA_NOPE + MLA_ROPE)), MLA_Q_RANK ** -0.5),
        'mla_kv_norm': 1.0 + nrm((L, MLA_KV_RANK), 0.02),
        'mla_w_ukv': nrm((L, MLA_KV_RANK, H * (MLA_NOPE + MLA_V)), MLA_KV_RANK ** -0.5),
        'swa_sink': nrm((L, H), 0.5),
        'w_out': nrm((L, MIX_WIDTH, D), MIX_WIDTH ** -0.5),
        'peer_wq': nrm((L, D, PEER_HEADS * 2 * PEER_DKEY), D ** -0.5),
        'peer_keys': nrm((L, PEER_HEADS, 2, PEER_NKEYS, PEER_DKEY), PEER_DKEY ** -0.5),
        'peer_u': nrm((L, PEER_EXPERTS, D), D ** -0.5),
        'peer_v': nrm((L, PEER_EXPERTS, D), 0.5),
        'final_norm_g': 1.0 + nrm((D,), 0.02),
    }


def reference(x, c, ctx, c_ctx, norm1_g, norm2_g, w_ada, b_ada, w_in, na_rpb, ml_conv, ml_gate_b,
              mla_q_norm, mla_w_uq, mla_kv_norm, mla_w_ukv, swa_sink, w_out,
              peer_wq, peer_keys, peer_u, peer_v, final_norm_g):
    T = x.shape[1]
    angs_mla = axial_angles(T, MLA_ROPE)
    angs_swa = axial_angles(T, HEAD_DIM)
    xc = ctx
    for l in range(DEPTH):
        x, xc = hybrid_layer(x, xc, c, c_ctx, l < DEPTH - 1, angs_mla, angs_swa,
                             norm1_g[l], norm2_g[l], w_ada[l], b_ada[l], w_in[l], na_rpb[l],
                             ml_conv[l], ml_gate_b[l], mla_q_norm[l], mla_w_uq[l], mla_kv_norm[l],
                             mla_w_ukv[l], swa_sink[l], w_out[l], peer_wq[l], peer_keys[l],
                             peer_u[l], peer_v[l])
    return rmsnorm(x, final_norm_g)
```

```cpp
#include <hip/hip_runtime.h>
#include <hip/hip_cooperative_groups.h>
#include <cstdio>
#include <cstdint>
namespace cg = cooperative_groups;

typedef unsigned short bf16_t;
typedef short bf16x8 __attribute__((ext_vector_type(8)));
typedef short s16x4 __attribute__((ext_vector_type(4)));
typedef float f32x16 __attribute__((ext_vector_type(16)));
typedef float f32x4 __attribute__((ext_vector_type(4)));
typedef float f32x2 __attribute__((ext_vector_type(2)));
typedef unsigned u32x4 __attribute__((ext_vector_type(4)));
typedef unsigned u32x2 __attribute__((ext_vector_type(2)));
typedef __bf16 bf2_t __attribute__((ext_vector_type(2)));

#define DI __device__ __forceinline__
#define MFMA32(a, b, c) __builtin_amdgcn_mfma_f32_32x32x16_bf16((a), (b), (c), 0, 0, 0)

constexpr int D = 1024, NB = 2, T = 16384, CTXL = 256;
constexpr int P = T + CTXL;
constexpr int NTOK = NB * P;
constexpr int NCH = P / 64;
constexpr int PJ = 2736;
constexpr int PJP = 2816;
constexpr int C_NAQ = 0, C_NAK = 256, C_NAV = 512, C_MLQ = 768, C_MLK = 1024, C_MLV = 1280, C_MLO = 1536, C_MLG = 1792,
              C_CQ = 1808, C_CKV = 2064, C_KR = 2192, C_SWQ = 2224, C_SWK = 2480, C_SWV = 2608;
constexpr float EPS = 1e-6f;
constexpr float LOG2E = 1.4426950408889634f;
constexpr int NEXP = 16384;

constexpr size_t al256(size_t x) { return (x + 255) & ~(size_t)255; }
constexpr size_t OFF_CTL = 0;
constexpr size_t OFF_BAR = 1024;
constexpr size_t CTL_BYTES = 16384;
constexpr size_t OFF_MOD = CTL_BYTES;
constexpr size_t OFF_XC = al256(OFF_MOD + 2 * 3 * 6144 * 4);
constexpr size_t OFF_WIN = al256(OFF_XC + (size_t)NB * CTXL * D * 4);
constexpr size_t OFF_WOUT = al256(OFF_WIN + (size_t)2 * PJP * D * 2);
constexpr size_t OFF_WQ = al256(OFF_WOUT + (size_t)2 * D * D * 2);
constexpr size_t OFF_KEYS = al256(OFF_WQ + (size_t)2 * 2048 * D * 2);
constexpr size_t OFF_WUQ = al256(OFF_KEYS + (size_t)2 * 16 * 128 * 128 * 2);
constexpr size_t OFF_WUKV = al256(OFF_WUQ + (size_t)2 * 384 * 256 * 2);
constexpr size_t OFF_PU = al256(OFF_WUKV + (size_t)2 * 512 * 128 * 2);
constexpr size_t OFF_PV = al256(OFF_PU + (size_t)NEXP * D * 2);
constexpr size_t OFF_ACT = al256(OFF_PV + (size_t)NEXP * D * 2);
constexpr size_t OFF_PROJ = al256(OFF_ACT + (size_t)NTOK * D * 2);
constexpr size_t OFF_GATES = al256(OFF_PROJ + (size_t)NTOK * PJ * 2);
constexpr size_t OFF_QM = al256(OFF_GATES + (size_t)NTOK * 16 * 4);
constexpr size_t OFF_KM = al256(OFF_QM + (size_t)NTOK * 384 * 2);
constexpr size_t OFF_VTM = al256(OFF_KM + (size_t)NTOK * 384 * 2);
constexpr size_t OFF_QC = al256(OFF_VTM + (size_t)NB * 4 * 64 * P * 2);
constexpr size_t OFF_KC = al256(OFF_QC + (size_t)NTOK * 256 * 2);
constexpr size_t OFF_UB = al256(OFF_KC + (size_t)NTOK * 256 * 2);
constexpr size_t OFF_UN = al256(OFF_UB + (size_t)16 * NCH * 4096 * 2);
constexpr size_t OFF_META = al256(OFF_UN + (size_t)16 * NCH * 64 * 4);
constexpr size_t OFF_GB = al256(OFF_META + (size_t)16 * NCH * 4 * 4);
constexpr size_t OFF_EIDX = al256(OFF_GB + (size_t)2 * NTOK * 4 * 2 * 4);
constexpr size_t OFF_GATE = al256(OFF_EIDX + (size_t)NTOK * 128 * 4);
constexpr size_t OFF_PSC = al256(OFF_GATE + (size_t)NTOK * 128 * 4);
constexpr size_t WS_END = al256(OFF_PSC + (size_t)2 * 2 * NEXP * 4);

constexpr int LDS_BYTES = 76 * 1024;
constexpr size_t OFF_SUE = OFF_QM;
constexpr size_t OFF_WQ8 = OFF_QM + (size_t)NTOK * 128 * 4;
constexpr size_t OFF_SW = OFF_WQ8 + (size_t)NTOK * 128;
constexpr size_t OFF_XQ = OFF_QC;
constexpr size_t OFF_SXQ = OFF_UN;
constexpr size_t OFF_LSTG = OFF_PROJ;
constexpr size_t OFF_PD = OFF_PROJ + (size_t)40 * 1024 * 1024;
constexpr size_t OFF_HQ = OFF_ACT;
constexpr size_t OFF_SH = OFF_ACT + (size_t)NTOK * D;
constexpr size_t OFF_SWIN = OFF_WIN + (size_t)2 * PJP * D;
constexpr size_t OFF_SWQ = OFF_WQ + (size_t)2 * 2048 * D;
constexpr size_t OFF_DELTA = OFF_QM;
constexpr int NPHASE = 22;

struct Params {
    const float* in[23];
    float* out;
    char* ws;
    int ph_lo, ph_hi;
};

DI unsigned pk2(float a, float b) { f32x2 v = {a, b}; bf2_t r = __builtin_convertvector(v, bf2_t); return __builtin_bit_cast(unsigned, r); }
DI float bflo(unsigned u) { return __uint_as_float(u << 16); }
DI float bfhi(unsigned u) { return __uint_as_float(u & 0xffff0000u); }
DI float bf2f(bf16_t v) { return __uint_as_float(((unsigned)v) << 16); }
DI bf16_t f2bf(float f) { return (bf16_t)(pk2(f, 0.f) & 0xffffu); }
DI int crow(int reg, int h) { return (reg & 3) + 8 * (reg >> 2) + 4 * h; }
DI float fmax2(float a, float b) { return __builtin_amdgcn_fmed3f(a, b, __builtin_inff()); }
DI float fexp2(float x) { return __builtin_amdgcn_exp2f(x); }
DI float fexp(float x) { return __builtin_amdgcn_exp2f(x * LOG2E); }
DI float siluf(float x) { return x / (1.f + __expf(-x)); }
DI float sigmoidf_(float x) { return 1.f / (1.f + __expf(-x)); }
DI float logsigmoidf_(float x) { return fminf(x, 0.f) - log1pf(__expf(-fabsf(x))); }
DI float shx(float v, int mask, int lane) { return __builtin_bit_cast(float, __builtin_amdgcn_ds_bpermute((lane ^ mask) << 2, __builtin_bit_cast(int, v))); }
DI unsigned shxu(unsigned v, int mask, int lane) { return (unsigned)__builtin_amdgcn_ds_bpermute((lane ^ mask) << 2, (int)v); }
DI float shfrom(float v, int src) { return __builtin_bit_cast(float, __builtin_amdgcn_ds_bpermute(src << 2, __builtin_bit_cast(int, v))); }

DI void sincos_cw(float x, float& s, float& c) {
    const float k = rintf(x * 0.6366197723675814f);
    float r = fmaf(k, -1.5707962512969971f, x);
    r = fmaf(k, -7.5497894158615964e-08f, r);
    const float r2 = r * r;
    float sp = fmaf(r2, 2.7557319e-6f, -1.9841270e-4f); sp = fmaf(sp, r2, 8.3333333e-3f); sp = fmaf(sp, r2, -1.6666667e-1f); sp = fmaf(sp * r2, r, r);
    float cp = fmaf(r2, 2.4801587e-5f, -1.3888889e-3f); cp = fmaf(cp, r2, 4.1666667e-2f); cp = fmaf(cp, r2, -0.5f); cp = fmaf(cp, r2, 1.f);
    const int q = ((int)k) & 3;
    const float ss = (q & 1) ? cp : sp, cc = (q & 1) ? sp : cp;
    s = (q & 2) ? -ss : ss;
    c = ((q + 1) & 2) ? -cc : cc;
}

DI int tok_b(int n) { return n >= P ? 1 : 0; }
DI const float* xin_row(const Params& p, int layer, int n) {
    const int b = tok_b(n), pos = n - b * P;
    if (layer == 0) return pos < CTXL ? p.in[2] + (size_t)(b * CTXL + pos) * D : p.in[0] + (size_t)(b * T + pos - CTXL) * D;
    return pos < CTXL ? (const float*)(p.ws + OFF_XC) + (size_t)(b * CTXL + pos) * D : p.out + (size_t)(b * T + pos - CTXL) * D;
}
DI float* xcur_row(const Params& p, int n) {
    const int b = tok_b(n), pos = n - b * P;
    return pos < CTXL ? (float*)(p.ws + OFF_XC) + (size_t)(b * CTXL + pos) * D : p.out + (size_t)(b * T + pos - CTXL) * D;
}
DI const float* mod_vec(const Params& p, int layer, int n) {
    const int b = tok_b(n), pos = n - b * P;
    return (const float*)(p.ws + OFF_MOD) + (size_t)(layer * 3 + (pos < CTXL ? 2 : b)) * 6144;
}

#ifndef PROBE_VARIANT
#define PROBE_VARIANT 0
#endif
#ifndef PROBE_HOT
#define PROBE_HOT 0
#endif
DI unsigned xb_xcc_id() { return (unsigned)__builtin_amdgcn_s_getreg((3 << 11) | 20) & 0xFu; }
DI int ltid() { int t = threadIdx.x; asm volatile("" : "+v"(t)); return t; }
DI int next_item(unsigned* ctr, volatile int* slot) {
    __syncthreads();
    if (threadIdx.x == 0) *slot = (int)atomicAdd(ctr, 1u);
    __syncthreads();
    return __builtin_amdgcn_readfirstlane(*slot);
}
DI void transpose_tile(const float* __restrict__ src, int K, int N, bf16_t* __restrict__ dst, const float* __restrict__ gain, int kt, int nt, char* lds) {
    float* tl = (float*)lds;
    const int tid = ltid();
    __syncthreads();
#pragma unroll
    for (int i = 0; i < 4; ++i) {
        const int c = tid + 256 * i;
        const int kr = c >> 4, nc = (c & 15) * 4;
        const int k = kt * 64 + kr, n = nt * 64 + nc;
        f32x4 v = {0.f, 0.f, 0.f, 0.f};
        if (n < N) v = *(const f32x4*)(src + (size_t)k * N + n);
        if (gain) { const float g = gain[k]; v *= g; }
        tl[kr * 65 + nc + 0] = v[0]; tl[kr * 65 + nc + 1] = v[1]; tl[kr * 65 + nc + 2] = v[2]; tl[kr * 65 + nc + 3] = v[3];
    }
    __syncthreads();
#pragma unroll
    for (int i = 0; i < 2; ++i) {
        const int c = tid + 256 * i;
        const int nr = c >> 3, kc = (c & 7) * 8;
        u32x4 o;
        o[0] = pk2(tl[(kc + 0) * 65 + nr], tl[(kc + 1) * 65 + nr]);
        o[1] = pk2(tl[(kc + 2) * 65 + nr], tl[(kc + 3) * 65 + nr]);
        o[2] = pk2(tl[(kc + 4) * 65 + nr], tl[(kc + 5) * 65 + nr]);
        o[3] = pk2(tl[(kc + 6) * 65 + nr], tl[(kc + 7) * 65 + nr]);
        *(u32x4*)(dst + (size_t)(nt * 64 + nr) * K + kt * 64 + kc) = o;
    }
}

DI void convert_item(const float* __restrict__ src, bf16_t* __restrict__ dst, int item) {
    const size_t base = (size_t)item * 8192 + ltid() * 8;
#pragma unroll
    for (int i = 0; i < 4; ++i) {
        const size_t o = base + (size_t)i * 2048;
        const f32x4 a = *(const f32x4*)(src + o), b = *(const f32x4*)(src + o + 4);
        u32x4 r; r[0] = pk2(a[0], a[1]); r[1] = pk2(a[2], a[3]); r[2] = pk2(b[0], b[1]); r[3] = pk2(b[2], b[3]);
        *(u32x4*)(dst + o) = r;
    }
}

DI void adaln_item(const Params& p, int item, char* lds) {
    float* sv = (float*)lds;
    float* red = sv + 3 * 1024;
    const int tid = ltid();
    const int l = item / 96, cc = item % 96;
    __syncthreads();
    for (int i = tid; i < 3 * 1024; i += 256) {
        const int v = i >> 10, k = i & 1023;
        const float x = v < 2 ? p.in[1][v * 1024 + k] : p.in[3][k];
        sv[i] = siluf(x);
    }
    __syncthreads();
    const int col = cc * 64 + (tid & 63), ks = tid >> 6;
    const float* w = p.in[6] + (size_t)l * 1024 * 6144 + col;
    float a0 = 0.f, a1 = 0.f, a2 = 0.f;
#pragma unroll 8
    for (int k = ks * 256; k < ks * 256 + 256; ++k) {
        const float wv = w[(size_t)k * 6144];
        a0 = fmaf(wv, sv[k], a0); a1 = fmaf(wv, sv[1024 + k], a1); a2 = fmaf(wv, sv[2048 + k], a2);
    }
    red[(ks * 3 + 0) * 64 + (tid & 63)] = a0; red[(ks * 3 + 1) * 64 + (tid & 63)] = a1; red[(ks * 3 + 2) * 64 + (tid & 63)] = a2;
    __syncthreads();
    if (tid < 192) {
        const int v = tid >> 6, c = tid & 63;
        const float s = red[(0 * 3 + v) * 64 + c] + red[(1 * 3 + v) * 64 + c] + red[(2 * 3 + v) * 64 + c] + red[(3 * 3 + v) * 64 + c];
        const int gc = cc * 64 + c;
        ((float*)(p.ws + OFF_MOD))[(size_t)(l * 3 + v) * 6144 + gc] = s + p.in[7][l * 6144 + gc];
    }
}

constexpr int TR_WIN = 16 * 44, TR_WOUT = 16 * 16, TR_WQ = 16 * 32, TR_WUQ = 4 * 6, TR_WUKV = 2 * 8;
constexpr int CS_LAYER = 44 + 32;
constexpr int TR_LAYER = CS_LAYER + TR_WOUT + TR_WUQ + TR_WUKV;
constexpr int Q8_LAYER = TR_WIN + TR_WQ;
DI void colscale_item(const Params& p, int l, int t, char* lds) {
    const bool isq = t >= 44;
    const int strip = isq ? t - 44 : t, N = isq ? 2048 : PJ;
    const float* src = isq ? p.in[18] + (size_t)l * D * 2048 : p.in[8] + (size_t)l * D * PJ;
    float* dst = isq ? (float*)(p.ws + OFF_SWQ) + l * 2048 : (float*)(p.ws + OFF_SWIN) + l * PJP;
    const int tid = ltid(), c = strip * 64 + (tid & 63), ks = tid >> 6;
    float am = 0.f;
    if (c < N) { for (int k = ks * 256; k < ks * 256 + 256; ++k) am = fmaxf(am, fabsf(src[(size_t)k * N + c])); }
    float* red = (float*)lds;
    __syncthreads();
    red[tid] = am;
    __syncthreads();
    if (tid < 64) { am = fmaxf(fmaxf(red[tid], red[64 + tid]), fmaxf(red[128 + tid], red[192 + tid])); dst[c] = am > 0.f ? am * (1.f / 127.f) : 1.f; }
}
DI void transpose_q8_tile(const float* __restrict__ src, int N, unsigned char* __restrict__ dst, const float* __restrict__ scale, int kt, int nt, char* lds) {
    float* tl = (float*)lds;
    const int tid = ltid();
    __syncthreads();
#pragma unroll
    for (int i = 0; i < 4; ++i) {
        const int c = tid + 256 * i, kr = c >> 4, nc = (c & 15) * 4;
        const int k = kt * 64 + kr, n = nt * 64 + nc;
        f32x4 v = {0.f, 0.f, 0.f, 0.f};
        if (n < N) { v = *(const f32x4*)(src + (size_t)k * N + n); const f32x4 sc = *(const f32x4*)(scale + n); v[0] /= sc[0]; v[1] /= sc[1]; v[2] /= sc[2]; v[3] /= sc[3]; }
        tl[kr * 65 + nc + 0] = v[0]; tl[kr * 65 + nc + 1] = v[1]; tl[kr * 65 + nc + 2] = v[2]; tl[kr * 65 + nc + 3] = v[3];
    }
    __syncthreads();
    {
        const int nr = tid >> 2, kc = (tid & 3) * 16;
        u32x4 o;
#pragma unroll
        for (int q = 0; q < 4; ++q) {
            unsigned pk = 0u;
#pragma unroll
            for (int e = 0; e < 4; ++e) pk |= ((unsigned)__float2int_rn(tl[(kc + 4 * q + e) * 65 + nr]) & 255u) << (8 * e);
            o[q] = pk;
        }
        *(u32x4*)(dst + (size_t)(nt * 64 + nr) * D + kt * 64 + kc) = o;
    }
}
DI void q8_item(const Params& p, int item, char* lds) {
    const int l = item / Q8_LAYER; int t = item % Q8_LAYER;
    if (t < TR_WIN) transpose_q8_tile(p.in[8] + (size_t)l * D * PJ, PJ, (unsigned char*)(p.ws + OFF_WIN) + (size_t)l * PJP * D, (const float*)(p.ws + OFF_SWIN) + l * PJP, t / 44, t % 44, lds);
    else { t -= TR_WIN; transpose_q8_tile(p.in[18] + (size_t)l * D * 2048, 2048, (unsigned char*)(p.ws + OFF_WQ) + (size_t)l * 2048 * D, (const float*)(p.ws + OFF_SWQ) + l * 2048, t / 32, t % 32, lds); }
}

constexpr int TAB_ITEMS = 2 * NEXP / 64;
constexpr int P0_ADA = 192;
constexpr int P0_TR = 2 * TR_LAYER;
constexpr int P0_KEYS = 2 * 32;
constexpr int P0_ROWS = 2 * 2 * NEXP / 4;
constexpr int P0_TOTAL = P0_ADA + P0_TR + P0_KEYS + P0_ROWS;

DI void table_fp8_item(const Params& p, int item) {
    const int lane = ltid() & 63, w = ltid() >> 6;
    const int rid = item * 4 + w;
    const int layer = rid / (2 * NEXP), tb = (rid / NEXP) & 1, row = rid % NEXP;
    const float* src = (tb == 0 ? p.in[20] : p.in[21]) + ((size_t)layer * NEXP + row) * D + 16 * lane;
    f32x4 v[4];
#pragma unroll
    for (int i = 0; i < 4; ++i) v[i] = *(const f32x4*)(src + 4 * i);
    float am = 0.f;
#pragma unroll
    for (int i = 0; i < 4; ++i)
#pragma unroll
        for (int e = 0; e < 4; ++e) am = fmaxf(am, fabsf(v[i][e]));
#pragma unroll
    for (int o = 32; o > 0; o >>= 1) am = fmaxf(am, shx(am, o, lane));
    const float sc = am > 0.f ? am * (1.f / 127.f) : 1.f;
    const float inv = 1.f / sc;
    u32x4 o;
#pragma unroll
    for (int i = 0; i < 4; ++i) {
        unsigned pk = 0u;
#pragma unroll
        for (int e = 0; e < 4; ++e) pk |= ((unsigned)__float2int_rn(v[i][e] * inv) & 255u) << (8 * e);
        o[i] = pk;
    }
    unsigned char* dst = (unsigned char*)(p.ws + (tb == 0 ? OFF_PU : OFF_PV)) + (size_t)layer * NEXP * D + (size_t)(lane >> 3) * NEXP * 128 + (size_t)row * 128 + 16 * (lane & 7);
    *(u32x4*)dst = o;
    if (lane == 0) ((float*)(p.ws + OFF_PSC))[(size_t)(layer * 2 + tb) * NEXP + row] = sc;
}
DI void table_item(const Params& p, int layer, int it) { for (int q = 0; q < 16; ++q) table_fp8_item(p, (layer * TAB_ITEMS + it) * 16 + q); }

DI void phase0_item(const Params& p, int item, char* lds) {
    if (item < P0_ADA) { adaln_item(p, item, lds); return; }
    item -= P0_ADA;
    if (item < P0_TR) {
        const int l = item / TR_LAYER; int t = item % TR_LAYER;
        if (t < CS_LAYER) { colscale_item(p, l, t, lds); return; }
        t -= CS_LAYER;
        if (t < TR_WOUT) { transpose_tile(p.in[17] + (size_t)l * D * D, D, D, (bf16_t*)(p.ws + OFF_WOUT) + (size_t)l * D * D, nullptr, t / 16, t % 16, lds); return; }
        t -= TR_WOUT;
        if (t < TR_WUQ) { transpose_tile(p.in[13] + (size_t)l * 256 * 384, 256, 384, (bf16_t*)(p.ws + OFF_WUQ) + (size_t)l * 384 * 256, p.in[12] + l * 256, t / 6, t % 6, lds); return; }
        t -= TR_WUQ;
        transpose_tile(p.in[15] + (size_t)l * 128 * 512, 128, 512, (bf16_t*)(p.ws + OFF_WUKV) + (size_t)l * 512 * 128, p.in[14] + l * 128, t / 8, t % 8, lds);
        return;
    }
    item -= P0_TR;
    if (item < P0_KEYS) { const int l = item / 32; convert_item(p.in[19] + (size_t)l * 262144, (bf16_t*)(p.ws + OFF_KEYS) + (size_t)l * 262144, item % 32); return; }
    item -= P0_KEYS;
    table_fp8_item(p, item);
}

DI void load_row16(const float* __restrict__ row, int lane, f32x4 (&v)[4]) {
#pragma unroll
    for (int i = 0; i < 4; ++i) v[i] = *(const f32x4*)(row + 4 * lane + 256 * i);
}
DI float wave_sum(float s, int lane) {
#pragma unroll
    for (int o = 32; o > 0; o >>= 1) s += shx(s, o, lane);
    return s;
}
DI float row_rstd(const f32x4 (&v)[4], int lane) {
    float s = 0.f;
#pragma unroll
    for (int i = 0; i < 4; ++i) s += v[i][0] * v[i][0] + v[i][1] * v[i][1] + v[i][2] * v[i][2] + v[i][3] * v[i][3];
    s = wave_sum(s, lane);
    return rsqrtf(s * (1.f / 1024.f) + EPS);
}
DI void norm_mod_store(const f32x4 (&v)[4], float rstd, const float* __restrict__ g, const float* __restrict__ sc, const float* __restrict__ sh, bf16_t* __restrict__ orow, int lane) {
#pragma unroll
    for (int i = 0; i < 4; ++i) {
        const int c = 4 * lane + 256 * i;
        const f32x4 gv = *(const f32x4*)(g + c), scv = *(const f32x4*)(sc + c), shv = *(const f32x4*)(sh + c);
        f32x4 y;
#pragma unroll
        for (int e = 0; e < 4; ++e) y[e] = fmaf(v[i][e] * rstd * gv[e], 1.f + scv[e], shv[e]);
        u32x2 o; o[0] = pk2(y[0], y[1]); o[1] = pk2(y[2], y[3]);
        *(u32x2*)(orow + c) = o;
    }
}

DI void phase_norm(const Params& p, int layer, int which, bool from_input) {
    const int lane = ltid() & 63;
    const int gw = blockIdx.x * 4 + (ltid() >> 6), nw = gridDim.x * 4;
    const float* g = (which == 0 ? p.in[4] : p.in[5]) + layer * 1024;
    for (int n = gw; n < NTOK; n += nw) {
        const float* row = from_input ? xin_row(p, 0, n) : xcur_row(p, n);
        f32x4 v[4]; load_row16(row, lane, v);
        const float rstd = row_rstd(v, lane);
        const float* mv = mod_vec(p, layer, n) + which * 3072;
        {
            f32x4 y[4]; float am = 0.f;
#pragma unroll
            for (int i = 0; i < 4; ++i) {
                const int c = 4 * lane + 256 * i;
                const f32x4 gv = *(const f32x4*)(g + c), scv = *(const f32x4*)(mv + 1024 + c), shv = *(const f32x4*)(mv + c);
#pragma unroll
                for (int e = 0; e < 4; ++e) { y[i][e] = fmaf(v[i][e] * rstd * gv[e], 1.f + scv[e], shv[e]); am = fmaxf(am, fabsf(y[i][e])); }
            }
#pragma unroll
            for (int o = 32; o > 0; o >>= 1) am = fmaxf(am, shx(am, o, lane));
            const float sc = am > 0.f ? am * (1.f / 127.f) : 1.f, inv = 1.f / sc;
            unsigned char* xq = (unsigned char*)(p.ws + (which == 1 ? OFF_XQ : OFF_HQ)) + (size_t)n * D;
#pragma unroll
            for (int i = 0; i < 4; ++i) {
                unsigned pk = 0u;
#pragma unroll
                for (int e = 0; e < 4; ++e) pk |= ((unsigned)__float2int_rn(y[i][e] * inv) & 255u) << (8 * e);
                *(unsigned*)(xq + 4 * lane + 256 * i) = pk;
            }
            if (lane == 0) ((float*)(p.ws + (which == 1 ? OFF_SXQ : OFF_SH)))[n] = sc;
        }
    }
}
constexpr int G_LD = 72;
constexpr int G_TILE = 128 * G_LD * 2;
constexpr int G_STAGE = 2 * G_TILE;
constexpr int G_LDS = 2 * G_STAGE;

typedef __attribute__((address_space(3))) char lchar_t;
typedef __attribute__((address_space(1))) const char gchar_t;
constexpr int GD_TILE = 128 * 128;
constexpr int GD_STAGE = 2 * GD_TILE;
template <int TRANS>
DI void gemm128(const bf16_t* __restrict__ A, int lda, const bf16_t* __restrict__ Bt, int ldb, int K, char* lds, f32x16 (&acc)[2][2], bool rt_trans = false, bool probe = false) {
    const int tid = ltid(), lane = tid & 63, w = tid >> 6, wr = w >> 1, wc = w & 1;
    const int r = lane & 31, h = lane >> 5;
    const int drow = 8 * w + (lane >> 3), dc = (lane & 7) ^ ((drow >> 1) & 7);
    const bf16_t* ap = A + (size_t)drow * lda + dc * 8;
    const bf16_t* bp = Bt + (size_t)drow * ldb + dc * 8;
    lchar_t* l3 = (lchar_t*)lds + (8 * w) * 128;
    const int swz = (r >> 1) & 7;
    (void)probe;
#pragma unroll
    for (int i = 0; i < 2; ++i)
#pragma unroll
        for (int j = 0; j < 2; ++j)
#pragma unroll
            for (int e = 0; e < 16; ++e) acc[i][j][e] = 0.f;
    const int KT = K >> 6;
#define G_DMA(stage_, kt_) { const int ko_ = (kt_) * 64; _Pragma("unroll") for (int j = 0; j < 4; ++j) {                                   \
        __builtin_amdgcn_global_load_lds((gchar_t*)(ap + (size_t)(32 * j) * lda + ko_), l3 + (stage_) * GD_STAGE + (32 * j) * 128, 16, 0, 0);           \
        __builtin_amdgcn_global_load_lds((gchar_t*)(bp + (size_t)(32 * j) * ldb + ko_), l3 + (stage_) * GD_STAGE + GD_TILE + (32 * j) * 128, 16, 0, 0); } }
    __syncthreads();
    G_DMA(0, 0);
    for (int kt = 0; kt < KT; ++kt) {
        asm volatile("s_waitcnt vmcnt(0)" ::: "memory");
        __syncthreads();
        if (kt + 1 < KT) G_DMA((kt + 1) & 1, kt + 1);
        const char* cur = lds + (kt & 1) * GD_STAGE;
#pragma unroll
        for (int ks = 0; ks < 4; ++ks) {
            bf16x8 af[2], bfr[2];
            const int co = ((ks * 2 + h) ^ swz) * 16;
#pragma unroll
            for (int i = 0; i < 2; ++i) af[i] = *(const bf16x8*)(cur + (wr * 64 + i * 32 + r) * 128 + co);
#pragma unroll
            for (int j = 0; j < 2; ++j) bfr[j] = *(const bf16x8*)(cur + GD_TILE + (wc * 64 + j * 32 + r) * 128 + co);
#pragma unroll
            for (int i = 0; i < 2; ++i)
#pragma unroll
                for (int j = 0; j < 2; ++j) {
                    if (TRANS == 1) acc[i][j] = MFMA32(bfr[j], af[i], acc[i][j]);
                    else if (TRANS == 0) acc[i][j] = MFMA32(af[i], bfr[j], acc[i][j]);
                    else { const bf16x8 x = rt_trans ? bfr[j] : af[i], y = rt_trans ? af[i] : bfr[j]; acc[i][j] = MFMA32(x, y, acc[i][j]); }
                }
        }
    }
    __syncthreads();
#undef G_DMA
}

typedef int i32x4 __attribute__((ext_vector_type(4)));
typedef int i32x16 __attribute__((ext_vector_type(16)));
DI void gemm128_i8(const unsigned char* __restrict__ A, int lda, const unsigned char* __restrict__ Bt, int ldb, int K, char* lds, i32x16 (&acc)[2][2]) {
    const int tid = ltid(), lane = tid & 63, w = tid >> 6, wr = w >> 1, wc = w & 1;
    const int r = lane & 31, h = lane >> 5;
    const int drow = 8 * w + (lane >> 3), dc = (lane & 7) ^ ((drow >> 1) & 7);
    const unsigned char* ap = A + (size_t)drow * lda + dc * 16;
    const unsigned char* bp = Bt + (size_t)drow * ldb + dc * 16;
    lchar_t* l3 = (lchar_t*)lds + (8 * w) * 128;
    const int swz = (r >> 1) & 7;
#pragma unroll
    for (int i = 0; i < 2; ++i)
#pragma unroll
        for (int j = 0; j < 2; ++j)
#pragma unroll
            for (int e = 0; e < 16; ++e) acc[i][j][e] = 0;
    const int KT = K >> 7;
#define G_DMA8(stage_, kt_) { const int ko_ = (kt_) * 128; _Pragma("unroll") for (int j = 0; j < 4; ++j) {                                   \
        __builtin_amdgcn_global_load_lds((gchar_t*)(ap + (size_t)(32 * j) * lda + ko_), l3 + (stage_) * GD_STAGE + (32 * j) * 128, 16, 0, 0);           \
        __builtin_amdgcn_global_load_lds((gchar_t*)(bp + (size_t)(32 * j) * ldb + ko_), l3 + (stage_) * GD_STAGE + GD_TILE + (32 * j) * 128, 16, 0, 0); } }
    __syncthreads();
    G_DMA8(0, 0);
    for (int kt = 0; kt < KT; ++kt) {
        asm volatile("s_waitcnt vmcnt(0)" ::: "memory");
        __syncthreads();
        if (kt + 1 < KT) G_DMA8((kt + 1) & 1, kt + 1);
        const char* cur = lds + (kt & 1) * GD_STAGE;
#pragma unroll
        for (int ks = 0; ks < 4; ++ks) {
            i32x4 af[2], bfr[2];
            const int co = ((ks * 2 + h) ^ swz) * 16;
#pragma unroll
            for (int i = 0; i < 2; ++i) af[i] = *(const i32x4*)(cur + (wr * 64 + i * 32 + r) * 128 + co);
#pragma unroll
            for (int j = 0; j < 2; ++j) bfr[j] = *(const i32x4*)(cur + GD_TILE + (wc * 64 + j * 32 + r) * 128 + co);
#pragma unroll
            for (int i = 0; i < 2; ++i)
#pragma unroll
                for (int j = 0; j < 2; ++j) acc[i][j] = __builtin_amdgcn_mfma_i32_32x32x32_i8(bfr[j], af[i], acc[i][j], 0, 0, 0);
        }
    }
    __syncthreads();
#undef G_DMA8
}

constexpr int P1_NT = PJP / 128;
constexpr int P1_ITEMS = (NTOK / 128) * P1_NT;
#ifndef PROBE_HOT
#define PROBE_HOT 0
#endif
DI void p1_item(const Params& p, int layer, int item, char* lds, bool rep = false) {
    const int mt = item / P1_NT, nt = item % P1_NT;
    const int m0 = (PROBE_HOT && rep) ? 0 : mt * 128, n0 = (PROBE_HOT && rep) ? 0 : nt * 128;
    i32x16 acci[2][2];
    gemm128_i8((const unsigned char*)(p.ws + OFF_HQ) + (size_t)m0 * D, D, (const unsigned char*)(p.ws + OFF_WIN) + (size_t)layer * PJP * D + (size_t)n0 * D, D, D, lds, acci);
    const int lane = ltid() & 63, w = ltid() >> 6, wr = w >> 1, wc = w & 1, r = lane & 31, h = lane >> 5;
    bf16_t* proj = (bf16_t*)(p.ws + ((PROBE_HOT && rep) ? OFF_QM : OFF_PROJ)) + ((PROBE_HOT && rep) ? (size_t)(item & 63) * 128 * PJ : 0);
    float* gates = (float*)(p.ws + ((PROBE_HOT && rep) ? OFF_QC : OFF_GATES));
    const float* sH = (const float*)(p.ws + OFF_SH);
    const float* sW = (const float*)(p.ws + OFF_SWIN) + layer * PJP;
    f32x16 acc[2][2];
#pragma unroll
    for (int i = 0; i < 2; ++i) {
        const float sa = sH[m0 + wr * 64 + i * 32 + r];
#pragma unroll
        for (int j = 0; j < 2; ++j)
#pragma unroll
            for (int g = 0; g < 4; ++g) {
                const int f = n0 + wc * 64 + j * 32 + 8 * g + 4 * h;
                f32x4 sb = {0.f, 0.f, 0.f, 0.f};
                if (f < PJ) sb = *(const f32x4*)(sW + f);
#pragma unroll
                for (int e = 0; e < 4; ++e) acc[i][j][4 * g + e] = (float)acci[i][j][4 * g + e] * (sa * sb[e]);
            }
    }
    bf16_t* T = (bf16_t*)lds;
#pragma unroll
    for (int i = 0; i < 2; ++i) {
        const int tl = wr * 64 + i * 32 + r, tok = m0 + tl;
#pragma unroll
        for (int j = 0; j < 2; ++j)
#pragma unroll
            for (int g = 0; g < 4; ++g) {
                const int fl = wc * 64 + j * 32 + 8 * g + 4 * h, f = n0 + fl;
                u32x2 o; o[0] = pk2(acc[i][j][4 * g], acc[i][j][4 * g + 1]); o[1] = pk2(acc[i][j][4 * g + 2], acc[i][j][4 * g + 3]);
                *(u32x2*)(T + tl * 136 + fl) = o;
                if (f >= C_MLG && f < C_MLG + 16) {
                    f32x4 gv = {acc[i][j][4 * g], acc[i][j][4 * g + 1], acc[i][j][4 * g + 2], acc[i][j][4 * g + 3]};
                    *(f32x4*)(gates + (size_t)tok * 16 + (f - C_MLG)) = gv;
                }
            }
    }
    __syncthreads();
    if (PROBE_VARIANT == 5 && rep) { if (T[ltid() * 3] == 0x1234) proj[ltid()] = 1; return; }
    {
        const int t2 = ltid();
#pragma unroll
        for (int i = 0; i < 8; ++i) {
            const int c = t2 + 256 * i, row = c >> 4, c8 = (c & 15) * 8;
            if (n0 + c8 < PJ) *(u32x4*)(proj + (size_t)(m0 + row) * PJ + n0 + c8) = *(const u32x4*)(T + row * 136 + c8);
        }
    }
}

constexpr int P5_ITEMS = (NTOK / 128) * 8;
DI void p5_item(const Params& p, int layer, int item, char* lds) {
    const int mt = item >> 3, nt = item & 7;
    const int m0 = mt * 128, n0 = nt * 128;
    f32x16 acc[2][2];
    gemm128<1>((const bf16_t*)(p.ws + OFF_ACT) + (size_t)m0 * D, D, (const bf16_t*)(p.ws + OFF_WOUT) + (size_t)layer * D * D + (size_t)n0 * D, D, D, lds, acc);
    const int lane = ltid() & 63, w = ltid() >> 6, wr = w >> 1, wc = w & 1, r = lane & 31, h = lane >> 5;
    float* T = (float*)lds;
#pragma unroll
    for (int i = 0; i < 2; ++i) {
        const int tl = wr * 64 + i * 32 + r;
#pragma unroll
        for (int j = 0; j < 2; ++j)
#pragma unroll
            for (int g = 0; g < 4; ++g) {
                f32x4 o = {acc[i][j][4 * g], acc[i][j][4 * g + 1], acc[i][j][4 * g + 2], acc[i][j][4 * g + 3]};
                *(f32x4*)(T + tl * 132 + wc * 64 + j * 32 + 8 * g + 4 * h) = o;
            }
    }
    __syncthreads();
    {
        const int t2 = ltid();
        f32x4 xv[16];
#pragma unroll
        for (int i = 0; i < 16; ++i) { const int c = t2 + 256 * i, row = c >> 5, c4 = (c & 31) * 4; xv[i] = __builtin_nontemporal_load((const f32x4*)(xin_row(p, layer, m0 + row) + n0 + c4)); }
        __builtin_amdgcn_sched_barrier(0);
#pragma unroll
        for (int i = 0; i < 16; ++i) {
            const int c = t2 + 256 * i, row = c >> 5, c4 = (c & 31) * 4, tok = m0 + row;
            const f32x4 a = *(const f32x4*)(T + row * 132 + c4);
            const f32x4 gv = *(const f32x4*)(mod_vec(p, layer, tok) + 2048 + n0 + c4);
            f32x4 o;
#pragma unroll
            for (int e = 0; e < 4; ++e) o[e] = fmaf(gv[e], a[e], xv[i][e]);
            __builtin_nontemporal_store(o, (f32x4*)(xcur_row(p, tok) + n0 + c4));
        }
    }
}
struct AttnJob {
    const bf16_t* Q; int ldq;
    const bf16_t* K; int ldk;
    const bf16_t* V; int ldv;
    bf16_t* O; int ldo;
    int r0b, r0e, r1b, r1e;
    int tq0;
    float scale2;
    float sink2; int has_sink;
    int probe;
};
#ifndef PROBE_VARIANT
#define PROBE_VARIANT 0
#endif
constexpr int ATT_STG = 22016;
constexpr int ATT_RPB = 2 * ATT_STG;

template <int DQ, bool VT, int MODE>
DI void attn_job(const AttnJob& J, char* lds) {
    constexpr int LDK = DQ + 8, KCH = DQ / 8, NKL = DQ / 32, KSB = 64 * LDK * 2;
    const int tid = ltid(), lane = tid & 63, w = tid >> 6, r = lane & 31, h = lane >> 5;
    const float* rpb = (const float*)(lds + ATT_RPB);
    bf16x8 qf[DQ / 16];
#pragma unroll
    for (int ks = 0; ks < DQ / 16; ++ks) qf[ks] = *(const bf16x8*)(J.Q + (size_t)(w * 32 + r) * J.ldq + ks * 16 + 8 * h);
    const int n0t = (J.r0e - J.r0b) >> 6, n1t = (J.r1e - J.r1b) >> 6, nt = n0t + n1t;
    const int tq = J.tq0 + w * 32 + r, tqw = J.tq0 + w * 32;
    const int qrow = tq >> 6, qcol = tq & 63;
    int rs = qrow - 4; rs = rs < 0 ? 0 : (rs > 248 ? 248 : rs);
    int cs = qcol - 8; cs = cs < 0 ? 0 : (cs > 48 ? 48 : cs);

    u32x4 kregA[NKL], vregA[2], kregB[NKL], vregB[2];
    int krow_[NKL], kkc[NKL];
#pragma unroll
    for (int i = 0; i < NKL; ++i) { const int c = tid + 256 * i; krow_[i] = c / KCH; kkc[i] = (c % KCH) * 8; }
    const int vrow = tid >> 3, vkc = (tid & 7) * 8;
    const int vkey = tid & 63, vc = tid >> 6;

#define ATT_GLOAD(kreg, vreg, pos_)                                                                                         \
    {                                                                                                           \
        _Pragma("unroll") for (int i = 0; i < NKL; ++i) kreg[i] = *(const u32x4*)(J.K + (size_t)((pos_) + krow_[i]) * J.ldk + kkc[i]); \
        if (VT) { _Pragma("unroll") for (int i = 0; i < 2; ++i) vreg[i] = *(const u32x4*)(J.V + (size_t)(vrow + 32 * i) * J.ldv + (pos_) + vkc); } \
        else { _Pragma("unroll") for (int i = 0; i < 2; ++i) vreg[i] = *(const u32x4*)(J.V + (size_t)((pos_) + vkey) * J.ldv + (vc + 4 * i) * 8); } \
    }
#define ATT_LSTORE(kreg, vreg, st_)                                                                                         \
    {                                                                                                           \
        _Pragma("unroll") for (int i = 0; i < NKL; ++i) *(u32x4*)((st_) + (krow_[i] * LDK + kkc[i]) * 2) = kreg[i]; \
        if (VT) { _Pragma("unroll") for (int i = 0; i < 2; ++i) {                                               \
            u32x2 a_ = {vreg[i][0], vreg[i][1]}, b_ = {vreg[i][2], vreg[i][3]};                                 \
            *(u32x2*)((st_) + KSB + ((vrow + 32 * i) * 68 + vkc) * 2) = a_;                                     \
            *(u32x2*)((st_) + KSB + ((vrow + 32 * i) * 68 + vkc + 4) * 2) = b_; } }                             \
        else { _Pragma("unroll") for (int i = 0; i < 2; ++i) { bf16_t* vb_ = (bf16_t*)((st_) + KSB) + (size_t)((vc + 4 * i) * 8) * 68 + vkey; \
            _Pragma("unroll") for (int e = 0; e < 4; ++e) { vb_[(2 * e) * 68] = (bf16_t)(vreg[i][e] & 0xffffu); vb_[(2 * e + 1) * 68] = (bf16_t)(vreg[i][e] >> 16); } } } \
    }

    f32x16 o0, o1, la;
#pragma unroll
    for (int e = 0; e < 16; ++e) { o0[e] = 0.f; o1[e] = 0.f; la[e] = 0.f; }
    float m = -1e30f;
    bf16x8 ones;
#pragma unroll
    for (int e = 0; e < 8; ++e) ones[e] = (short)0x3f80;
#define ATT_POS(i_) ((i_) < n0t ? J.r0b + 64 * (i_) : J.r1b + 64 * ((i_) - n0t))
    {
        ATT_GLOAD(kregA, vregA, ATT_POS(0));
        { const int i1_ = nt > 1 ? 1 : 0; ATT_GLOAD(kregB, vregB, ATT_POS(i1_)); }
        __syncthreads();
        ATT_LSTORE(kregA, vregA, lds);
        __builtin_amdgcn_s_waitcnt(0);
        __syncthreads();
    }
    for (int it0 = 0; it0 < nt; it0 += 2) {
#pragma unroll
      for (int par = 0; par < 2; ++par) {
        const int it = it0 + par;
        if (it >= nt) break;
        const int pos = ATT_POS(it);
        char* cur = lds + par * ATT_STG;
        { const int i2_ = it + 2 < nt ? it + 2 : nt - 1; const int np = ATT_POS(i2_);
          if (par == 0) { ATT_GLOAD(kregA, vregA, np); } else { ATT_GLOAD(kregB, vregB, np); } }
        __builtin_amdgcn_sched_barrier(0);
        const bool isctx = pos < CTXL;
        bool active = true;
        int key_row = 0;
        if (MODE == 1 && !isctx) { key_row = (pos - CTXL) >> 6; active = (key_row >= rs) && (key_row < rs + 8); }
        if (MODE == 2 && !isctx) { const int tk0 = pos - CTXL; active = (tk0 + 63 >= tqw - 128) && (tk0 <= tqw + 31 + 128); }
        if (active) {
            f32x16 s0, s1;
#pragma unroll
            for (int e = 0; e < 16; ++e) { s0[e] = 0.f; s1[e] = 0.f; }
            {
                bf16x8 kfa[DQ / 16], kfb[DQ / 16];
#pragma unroll
                for (int ks = 0; ks < DQ / 16; ++ks) {
                    kfa[ks] = *(const bf16x8*)(cur + (r * LDK + ks * 16 + 8 * h) * 2);
                    kfb[ks] = *(const bf16x8*)(cur + ((32 + r) * LDK + ks * 16 + 8 * h) * 2);
                }
                __builtin_amdgcn_sched_barrier(0);
                if (PROBE_VARIANT == 2 && J.probe) {
#pragma unroll
                    for (int e = 0; e < 8; ++e) { s0[e] = (float)kfa[0][e]; s1[e] = (float)kfb[0][e]; s0[8 + e] = (float)kfa[DQ / 16 - 1][e]; s1[8 + e] = (float)kfb[DQ / 16 - 1][e]; }
                } else {
#pragma unroll
                for (int ks = 0; ks < DQ / 16; ++ks) {
                    s0 = MFMA32(kfa[ks], qf[ks], s0);
                    s1 = MFMA32(kfb[ks], qf[ks], s1);
                }
                }
            }
            bf16x8 vfa[4], vfb[4];
            {
                const bf16_t* vb = (const bf16_t*)(cur + KSB);
#pragma unroll
                for (int st = 0; st < 4; ++st) {
                    const s16x4 lo0 = *(const s16x4*)(vb + r * 68 + 16 * st + 4 * h), hi0 = *(const s16x4*)(vb + r * 68 + 16 * st + 8 + 4 * h);
                    const s16x4 lo1 = *(const s16x4*)(vb + (32 + r) * 68 + 16 * st + 4 * h), hi1 = *(const s16x4*)(vb + (32 + r) * 68 + 16 * st + 8 + 4 * h);
                    vfa[st] = __builtin_shufflevector(lo0, hi0, 0, 1, 2, 3, 4, 5, 6, 7);
                    vfb[st] = __builtin_shufflevector(lo1, hi1, 0, 1, 2, 3, 4, 5, 6, 7);
                }
            }
            __builtin_amdgcn_sched_barrier(0);
            float mx = -1e30f;
            if (!(PROBE_VARIANT == 1 && J.probe)) {
            if (MODE == 1) {
#pragma unroll
                for (int e = 0; e < 16; ++e) {
                    float t0 = s0[e] * J.scale2, t1 = s1[e] * J.scale2;
                    if (!isctx) {
                        const int kc0 = crow(e, h), kc1 = 32 + crow(e, h);
                        const bool v0 = (kc0 >= cs) && (kc0 < cs + 16), v1 = (kc1 >= cs) && (kc1 < cs + 16);
                        const int rb = (key_row - qrow + 7) * 31 + 15 - qcol;
                        int i0 = rb + kc0, i1 = rb + kc1;
                        i0 = v0 ? i0 : 0; i1 = v1 ? i1 : 0;
                        t0 = v0 ? t0 + rpb[i0] : -1e30f;
                        t1 = v1 ? t1 + rpb[i1] : -1e30f;
                    }
                    s0[e] = t0; s1[e] = t1;
                    mx = fmax2(mx, fmax2(t0, t1));
                }
            } else {
#pragma unroll
                for (int e = 0; e < 16; ++e) {
                    if (MODE == 2 && !isctx) {
                        const int d0 = pos - CTXL + crow(e, h) - tq, d1 = d0 + 32;
                        s0[e] = (d0 <= 128 && d0 >= -128) ? s0[e] : -1e30f;
                        s1[e] = (d1 <= 128 && d1 >= -128) ? s1[e] : -1e30f;
                    }
                    mx = fmax2(mx, fmax2(s0[e], s1[e]));
                }
                mx *= J.scale2;
            }
            mx = fmax2(mx, shx(mx, 32, lane));
            const float mn = fmax2(m, mx);
            if (__builtin_amdgcn_ballot_w64(mn > m) != 0ull) {
                const float alpha = fexp2(m - mn);
#pragma unroll
                for (int e = 0; e < 16; ++e) { o0[e] *= alpha; o1[e] *= alpha; la[e] *= alpha; }
                m = mn;
            }
            if (MODE == 1) {
#pragma unroll
                for (int e = 0; e < 16; ++e) { s0[e] = fexp2(s0[e] - m); s1[e] = fexp2(s1[e] - m); }
            } else {
#pragma unroll
                for (int e = 0; e < 16; ++e) { s0[e] = fexp2(fmaf(s0[e], J.scale2, -m)); s1[e] = fexp2(fmaf(s1[e], J.scale2, -m)); }
            }
            }
            bf16x8 pf[4];
            {
                u32x4 t;
                t[0] = pk2(s0[0], s0[1]); t[1] = pk2(s0[2], s0[3]); t[2] = pk2(s0[4], s0[5]); t[3] = pk2(s0[6], s0[7]); pf[0] = __builtin_bit_cast(bf16x8, t);
                t[0] = pk2(s0[8], s0[9]); t[1] = pk2(s0[10], s0[11]); t[2] = pk2(s0[12], s0[13]); t[3] = pk2(s0[14], s0[15]); pf[1] = __builtin_bit_cast(bf16x8, t);
                t[0] = pk2(s1[0], s1[1]); t[1] = pk2(s1[2], s1[3]); t[2] = pk2(s1[4], s1[5]); t[3] = pk2(s1[6], s1[7]); pf[2] = __builtin_bit_cast(bf16x8, t);
                t[0] = pk2(s1[8], s1[9]); t[1] = pk2(s1[10], s1[11]); t[2] = pk2(s1[12], s1[13]); t[3] = pk2(s1[14], s1[15]); pf[3] = __builtin_bit_cast(bf16x8, t);
            }
            if (PROBE_VARIANT == 2 && J.probe) {
#pragma unroll
                for (int e = 0; e < 8; ++e) { o0[e] += (float)vfa[0][e] + (float)pf[0][e]; o1[e] += (float)vfb[3][e] + (float)pf[3][e]; o0[8 + e] += (float)vfa[1][e] + (float)pf[1][e]; o1[8 + e] += (float)vfb[2][e] + (float)pf[2][e]; }
            } else
#pragma unroll
            for (int st = 0; st < 4; ++st) {
                o0 = MFMA32(vfa[st], pf[st], o0);
                o1 = MFMA32(vfb[st], pf[st], o1);
                la = MFMA32(ones, pf[st], la);
            }
        }
        if (it + 1 < nt) { if (par == 0) { ATT_LSTORE(kregB, vregB, lds + ATT_STG); } else { ATT_LSTORE(kregA, vregA, lds); } }
        __syncthreads();
      }
    }
#undef ATT_GLOAD
#undef ATT_LSTORE
#undef ATT_POS
    float l = la[0];
    if (J.has_sink) l += fexp2(J.sink2 - m);
    const float inv = 1.f / l;
    bf16_t* orow = J.O + (size_t)(w * 32 + r) * J.ldo;
#pragma unroll
    for (int g = 0; g < 4; ++g) {
        u32x2 a; a[0] = pk2(o0[4 * g] * inv, o0[4 * g + 1] * inv); a[1] = pk2(o0[4 * g + 2] * inv, o0[4 * g + 3] * inv);
        *(u32x2*)(orow + 8 * g + 4 * h) = a;
        u32x2 b; b[0] = pk2(o1[4 * g] * inv, o1[4 * g + 1] * inv); b[1] = pk2(o1[4 * g + 2] * inv, o1[4 * g + 3] * inv);
        *(u32x2*)(orow + 32 + 8 * g + 4 * h) = b;
    }
}
typedef int i32x8 __attribute__((ext_vector_type(8)));
struct MlaJob { const unsigned char* Q; const unsigned char* K; const unsigned char* V; bf16_t* O; int ldo; int nkeys; };
constexpr int MX_STG = 8192 + 4096;
constexpr int MX_STG2 = 2 * MX_STG;
#define MFMA_MX(a, b, c) __builtin_amdgcn_mfma_scale_f32_32x32x64_f8f6f4((a), (b), (c), 0, 0, 0, 0x7f7f7f7f, 0, 0x7f7f7f7f)

DI void attn_mla_mx(const MlaJob& J, char* lds) {
    const int tid = ltid(), lane = tid & 63, w = tid >> 6, r = lane & 31, h = lane >> 5;
    i32x8 qf[2][2];
#pragma unroll
    for (int qs = 0; qs < 2; ++qs) {
        const unsigned char* qp = J.Q + (size_t)(w * 64 + qs * 32 + r) * 512 + 32 * h;
#pragma unroll
        for (int kb = 0; kb < 2; ++kb) {
            const u32x4 a = *(const u32x4*)(qp + 64 * kb), b = *(const u32x4*)(qp + 64 * kb + 16);
            qf[qs][kb][0] = a[0]; qf[qs][kb][1] = a[1]; qf[qs][kb][2] = a[2]; qf[qs][kb][3] = a[3]; qf[qs][kb][4] = b[0]; qf[qs][kb][5] = b[1]; qf[qs][kb][6] = b[2]; qf[qs][kb][7] = b[3];
        }
    }
    __builtin_amdgcn_s_waitcnt(0);
    __syncthreads();
    float c0 = -64.f, c1 = -64.f;
    if (h) { qf[0][1][0] = 0x68; qf[1][1][0] = 0x68; }
    const int krow = 8 * w + (lane >> 3), kc = (lane & 7) ^ ((krow >> 1) & 7);
    const unsigned char* kp = J.K + (size_t)krow * 128 + kc * 16;
    const int vrow = 16 * w + (lane >> 2), vc = (lane & 3) ^ ((vrow >> 2) & 3);
    const unsigned char* vp = J.V + (size_t)vrow * P + vc * 16;
    lchar_t* l3 = (lchar_t*)lds;
#define MX_DMA1(base_, pos_) {                                                                                                          \
        __builtin_amdgcn_global_load_lds((gchar_t*)(kp + (size_t)(pos_) * 128), l3 + (base_) + (8 * w) * 128, 16, 0, 0);                 \
        __builtin_amdgcn_global_load_lds((gchar_t*)(kp + (size_t)((pos_) + 32) * 128), l3 + (base_) + (32 + 8 * w) * 128, 16, 0, 0);     \
        __builtin_amdgcn_global_load_lds((gchar_t*)(vp + (pos_)), l3 + (base_) + 8192 + (16 * w) * 64, 16, 0, 0); }
#define MX_DMA(stage_, pair_) { MX_DMA1((stage_) * MX_STG2, (pair_) * 128); MX_DMA1((stage_) * MX_STG2 + MX_STG, (pair_) * 128 + 64); }
    const int np = J.nkeys >> 7;
    MX_DMA(0, 0);
    { const int t1 = np > 1 ? 1 : np - 1; MX_DMA(1, t1); }
    f32x16 o0[2], o1[2];
    float l0 = 0.f, l1 = 0.f;
#pragma unroll
    for (int qs = 0; qs < 2; ++qs)
#pragma unroll
        for (int e = 0; e < 16; ++e) { o0[qs][e] = 0.f; o1[qs][e] = 0.f; }
    f32x16 zero16;
#pragma unroll
    for (int e = 0; e < 16; ++e) zero16[e] = 0.f;
    const int ksw = (r >> 1) & 7, vsw = (r >> 2) & 3;
#define FADD(a_, b_) ({ float r_; asm("v_add_f32_e32 %0, %1, %2" : "=v"(r_) : "v"(a_), "v"(b_)); r_; })
#define SBAR() __builtin_amdgcn_sched_barrier(0)
#define TILE_BASE(tile_) (lds + (((tile_) >> 1) % 3) * MX_STG2 + ((tile_) & 1) * MX_STG)
#define MX_KREAD(dst_, tile_, u_) {                                                                                                     \
        const char* rp = TILE_BASE(tile_) + (32 * (u_) + r) * 128;                                                                      \
        _Pragma("unroll") for (int kb = 0; kb < 2; ++kb) {                                                                              \
            const u32x4 a = *(const u32x4*)(rp + (((4 * kb + 2 * h) ^ ksw) * 16)), b = *(const u32x4*)(rp + (((4 * kb + 2 * h + 1) ^ ksw) * 16)); \
            dst_[kb][0] = a[0]; dst_[kb][1] = a[1]; dst_[kb][2] = a[2]; dst_[kb][3] = a[3]; dst_[kb][4] = b[0]; dst_[kb][5] = b[1]; dst_[kb][6] = b[2]; dst_[kb][7] = b[3]; } }
#define MX_VREAD(tile_) {                                                                                                               \
        _Pragma("unroll") for (int d = 0; d < 2; ++d) {                                                                                 \
            const char* rp = TILE_BASE(tile_) + 8192 + (32 * d + r) * 64;                                                               \
            const u32x4 a = *(const u32x4*)(rp + (((2 * h) ^ vsw) * 16)), b = *(const u32x4*)(rp + (((2 * h + 1) ^ vsw) * 16));         \
            vf[d][0] = a[0]; vf[d][1] = a[1]; vf[d][2] = a[2]; vf[d][3] = a[3]; vf[d][4] = b[0]; vf[d][5] = b[1]; vf[d][6] = b[2]; vf[d][7] = b[3]; } }
#define MX_PACK(S_, qs_, u_) {                                                                                                          \
        _Pragma("unroll") for (int g = 0; g < 4; ++g) {                                                                                 \
            int a = __builtin_amdgcn_cvt_pk_fp8_f32(S_[4 * g], S_[4 * g + 1], 0, false);                                                \
            a = __builtin_amdgcn_cvt_pk_fp8_f32(S_[4 * g + 2], S_[4 * g + 3], a, true); pf[qs_][4 * (u_) + g] = a; } }
#define KEEP(x_) asm volatile("" :: "v"(x_))
#define MX_EXP(S_, a_, b_) { _Pragma("unroll") for (int e = (a_); e < (b_); ++e) S_[e] = fexp2(S_[e]); }
#define MX_SUMCHECK(S_, qs_, u_, cq_, lq_) {                                                                                            \
        float a0 = FADD(S_[0], S_[4]), a1 = FADD(S_[1], S_[5]), a2 = FADD(S_[2], S_[6]), a3 = FADD(S_[3], S_[7]);     \
        a0 = FADD(a0, S_[8]); a1 = FADD(a1, S_[9]); a2 = FADD(a2, S_[10]); a3 = FADD(a3, S_[11]);                                       \
        a0 = FADD(a0, S_[12]); a1 = FADD(a1, S_[13]); a2 = FADD(a2, S_[14]); a3 = FADD(a3, S_[15]);                                     \
        a0 = FADD(a0, a2); a1 = FADD(a1, a3);                                                                                           \
        float ts = FADD(a0, a1);                                                                                                        \
        if (__builtin_amdgcn_ballot_w64(ts > 128.f) != 0ull) {                                                                          \
            const float tf = ts + shx(ts, 32, lane);                                 \
            const bool bad = tf > 64.f;                                                                                                 \
            const float tg = -(cq_ + __builtin_amdgcn_logf(tf) - 4.f);                           \
            const int e1 = __builtin_amdgcn_cvt_pk_fp8_f32(tg, 0.f, 0, false);                                                          \
            const float d1 = __builtin_amdgcn_cvt_f32_fp8(e1, 0);                                                                       \
            const int e2 = __builtin_amdgcn_cvt_pk_fp8_f32(tg, tg - d1, 0, false);                                                      \
            const float cn = -(d1 + __builtin_amdgcn_cvt_f32_fp8(e2, 1));                                                               \
            const float f = bad ? fexp2(cq_ - cn) : 1.f;                                                                                \
            cq_ = bad ? cn : cq_; lq_ *= f; ts *= f;                                                                                    \
            if (h && bad) qf[qs_][1][0] = e2 & 0xffff;                                                                                  \
            _Pragma("unroll") for (int e = 0; e < 16; ++e) { o0[qs_][e] *= f; o1[qs_][e] *= f; S_[e] *= f; }                            \
            if ((u_) == 1) {                                           \
                _Pragma("unroll") for (int g = 0; g < 4; ++g) {                                                                         \
                    const int pw = pf[qs_][g];                                                                                          \
                    int a = __builtin_amdgcn_cvt_pk_fp8_f32(__builtin_amdgcn_cvt_f32_fp8(pw, 0) * f, __builtin_amdgcn_cvt_f32_fp8(pw, 1) * f, 0, false); \
                    a = __builtin_amdgcn_cvt_pk_fp8_f32(__builtin_amdgcn_cvt_f32_fp8(pw, 2) * f, __builtin_amdgcn_cvt_f32_fp8(pw, 3) * f, a, true);      \
                    pf[qs_][g] = a; } }                                                                                                 \
        }                                                                                                                               \
        lq_ += ts; }
    const int nt = 2 * np;
    asm volatile("s_waitcnt vmcnt(6) lgkmcnt(0)" ::: "memory");
    __builtin_amdgcn_s_barrier();
    { const int t2 = 2 < np ? 2 : np - 1; MX_DMA(2, t2); }
    i32x8 kfa[2], kfb[2];
    i32x8 vf[2], pf[2];
    f32x16 SA, SB;
#pragma unroll
    for (int e = 0; e < 16; ++e) SB[e] = 0.f;
#pragma unroll
    for (int e = 0; e < 8; ++e) { vf[0][e] = 0; vf[1][e] = 0; pf[0][e] = 0; pf[1][e] = 0; }
    MX_KREAD(kfa, 0, 0);
    MX_KREAD(kfb, 0, 1);
    SA = MFMA_MX(kfa[0], qf[0][0], zero16); SA = MFMA_MX(kfa[1], qf[0][1], SA);
#pragma unroll 1
    for (int t = 0; t < nt; ++t) {
        MX_PACK(SB, 1, 1);
        SBAR();
        o0[1] = MFMA_MX(vf[0], pf[1], o0[1]); KEEP(o0[1]);
        SBAR();
        MX_EXP(SA, 0, 6);
        SBAR();
        SB = MFMA_MX(kfa[0], qf[1][0], zero16); KEEP(SB);
        SBAR();
        MX_EXP(SA, 6, 12);
        SBAR();
        o1[1] = MFMA_MX(vf[1], pf[1], o1[1]); KEEP(o1[1]);
        SBAR();
        MX_EXP(SA, 12, 16);
        SBAR();
        SB = MFMA_MX(kfa[1], qf[1][1], SB); KEEP(SB);
        SBAR();
        MX_SUMCHECK(SA, 0, 0, c0, l0);
        SBAR();
        MX_PACK(SA, 0, 0);
        SBAR();
        SA = MFMA_MX(kfb[0], qf[0][0], zero16); KEEP(SA);
        MX_VREAD(t);
        SBAR();
        MX_EXP(SB, 0, 8);
        SBAR();
        SA = MFMA_MX(kfb[1], qf[0][1], SA); KEEP(SA);
        SBAR();
        MX_EXP(SB, 8, 16);
        MX_SUMCHECK(SB, 1, 0, c1, l1);
        SBAR();
        if ((t & 1) && t + 1 < nt) {
            asm volatile("s_waitcnt vmcnt(6) lgkmcnt(0)" ::: "memory");
            __builtin_amdgcn_s_barrier();
            const int ip3 = (t >> 1) + 3;
            { const int t2 = ip3 < np ? ip3 : np - 1; MX_DMA(ip3 % 3, t2); }
        }
        MX_KREAD(kfa, t + 1, 0);
        SBAR();
        MX_PACK(SB, 1, 0);
        SBAR();
        SB = MFMA_MX(kfb[0], qf[1][0], zero16); KEEP(SB);
        SBAR();
        MX_EXP(SA, 0, 8);
        SBAR();
        SB = MFMA_MX(kfb[1], qf[1][1], SB); KEEP(SB);
        SBAR();
        MX_EXP(SA, 8, 16);
        MX_SUMCHECK(SA, 0, 1, c0, l0);
        SBAR();
        MX_PACK(SA, 0, 1);
        SBAR();
        o0[0] = MFMA_MX(vf[0], pf[0], o0[0]); KEEP(o0[0]);
        MX_KREAD(kfb, t + 1, 1);
        SBAR();
        MX_EXP(SB, 0, 6);
        SBAR();
        SA = MFMA_MX(kfa[0], qf[0][0], zero16); KEEP(SA);
        SBAR();
        MX_EXP(SB, 6, 12);
        SBAR();
        o1[0] = MFMA_MX(vf[1], pf[0], o1[0]); KEEP(o1[0]);
        SBAR();
        MX_EXP(SB, 12, 16);
        SBAR();
        SA = MFMA_MX(kfa[1], qf[0][1], SA); KEEP(SA);
        SBAR();
        MX_SUMCHECK(SB, 1, 1, c1, l1);
        SBAR();
    }
    MX_PACK(SB, 1, 1);
    o0[1] = MFMA_MX(vf[0], pf[1], o0[1]);
    o1[1] = MFMA_MX(vf[1], pf[1], o1[1]);
    asm volatile("s_waitcnt vmcnt(0)" ::: "memory");
    const int tid2 = ltid(), lane2 = tid2 & 63, w2 = tid2 >> 6, r2 = lane2 & 31, h2 = lane2 >> 5;
    l0 += shx(l0, 32, lane2); l1 += shx(l1, 32, lane2);
#undef MX_DMA
#undef MX_DMA1
#undef MX_KREAD
#undef MX_VREAD
#undef MX_PACK
#undef MX_EXP
#undef MX_SUMCHECK
#undef KEEP
#undef TILE_BASE
#undef SBAR
#undef FADD
#pragma unroll
    for (int qs = 0; qs < 2; ++qs) {
        const float inv = 1.f / (qs ? l1 : l0);
        bf16_t* orow = J.O + (size_t)(w2 * 64 + qs * 32 + r2) * J.ldo;
#pragma unroll
        for (int g = 0; g < 4; ++g) {
            u32x2 a; a[0] = pk2(o0[qs][4 * g] * inv, o0[qs][4 * g + 1] * inv); a[1] = pk2(o0[qs][4 * g + 2] * inv, o0[qs][4 * g + 3] * inv);
            *(u32x2*)(orow + 8 * g + 4 * h2) = a;
            u32x2 b; b[0] = pk2(o1[qs][4 * g] * inv, o1[qs][4 * g + 1] * inv); b[1] = pk2(o1[qs][4 * g + 2] * inv, o1[qs][4 * g + 3] * inv);
            *(u32x2*)(orow + 32 + 8 * g + 4 * h2) = b;
        }
    }
}
constexpr int P2_MQ = (NTOK / 128) * 3, P2_MKV = (NTOK / 128) * 4, P2_ROPE = NB * T * 12 / 256, P2_ML = NB * 4 * NCH;
constexpr int P2_ITEMS = P2_MQ + P2_MKV + P2_ROPE + P2_ML;
constexpr int RS_OFF = G_LDS;

constexpr float INV8[8] = {1.f, 0.316227766f, 0.1f, 0.0316227766f, 0.01f, 0.00316227766f, 0.001f, 0.000316227766f};
constexpr float INV16[16] = {1.f, 0.562341325f, 0.316227766f, 0.177827941f, 0.1f, 0.0562341325f, 0.0316227766f, 0.0177827941f,
                             0.01f, 0.00562341325f, 0.00316227766f, 0.00177827941f, 0.001f, 0.000562341325f, 0.000316227766f, 0.000177827941f};

DI void rows_rstd(const bf16_t* __restrict__ A, int lda, int ncol, float* rsd) {
    const int tid = ltid(), row = tid >> 1, half = tid & 1;
    const int per = ncol >> 1;
    const bf16_t* a = A + (size_t)row * lda + half * per;
    float s = 0.f;
    for (int c = 0; c < per; c += 8) {
        const u32x4 v = *(const u32x4*)(a + c);
#pragma unroll
        for (int e = 0; e < 4; ++e) { const float x = bflo(v[e]), y = bfhi(v[e]); s = fmaf(x, x, s); s = fmaf(y, y, s); }
    }
    s += shx(s, 1, tid & 63);
    if (half == 0) rsd[row] = rsqrtf(s / (float)ncol + EPS);
}

DI void p2_mla_q(const Params& p, int layer, int item, char* lds) {
    const int mt = item / 3, nt = item % 3, m0 = mt * 128, n0 = nt * 128;
    const bf16_t* A = (const bf16_t*)(p.ws + OFF_PROJ) + (size_t)m0 * PJ + C_CQ;
    float* rsd = (float*)(lds + RS_OFF);
    __syncthreads();
    rows_rstd(A, PJ, 256, rsd);
    f32x16 acc[2][2];
    gemm128<1>(A, PJ, (const bf16_t*)(p.ws + OFF_WUQ) + (size_t)layer * 384 * 256 + (size_t)n0 * 256, 256, 256, lds, acc);
    const int lane = ltid() & 63, w = ltid() >> 6, wr = w >> 1, wc = w & 1, r = lane & 31, h = lane >> 5;
    unsigned char* Qm8 = (unsigned char*)(p.ws + OFF_QM);
#pragma unroll
    for (int i = 0; i < 2; ++i) {
        const int tl = wr * 64 + i * 32 + r, tok = m0 + tl;
        const float rs = rsd[tl] * (0.10206207261596577f * LOG2E);
        const int b = tok_b(tok), pos = tok - b * P;
#pragma unroll
        for (int j = 0; j < 2; ++j) {
            const int u = (n0 + wc * 64 + j * 32) >> 5, head = u / 3, part = u % 3;
            float v[16];
#pragma unroll
            for (int e = 0; e < 16; ++e) v[e] = acc[i][j][e] * rs;
            if (part == 2 && pos >= CTXL) {
                const int t = pos - CTXL;
                const float frow = (float)(t >> 6), fcol = (float)(t & 63);
#pragma unroll
                for (int e = 0; e < 4; ++e) {
                    const float inv = h ? INV8[4 + e] : INV8[e];
                    float s, c;
                    sincos_cw(frow * inv, s, c);
                    const float x1 = v[e], x2 = v[4 + e];
                    v[e] = x1 * c - x2 * s; v[4 + e] = x1 * s + x2 * c;
                    sincos_cw(fcol * inv, s, c);
                    const float y1 = v[8 + e], y2 = v[12 + e];
                    v[8 + e] = y1 * c - y2 * s; v[12 + e] = y1 * s + y2 * c;
                }
            }
            unsigned char* dst = Qm8 + ((size_t)tok * 4 + head) * 128 + part * 32;
#pragma unroll
            for (int g = 0; g < 4; ++g) {
                int pk = __builtin_amdgcn_cvt_pk_fp8_f32(v[4 * g], v[4 * g + 1], 0, false);
                pk = __builtin_amdgcn_cvt_pk_fp8_f32(v[4 * g + 2], v[4 * g + 3], pk, true);
                *(int*)(dst + 8 * g + 4 * h) = pk;
            }
            if (part == 2 && h == 0) { const u32x4 z = {0u, 0u, 0u, 0u}; *(u32x4*)(dst + 32) = z; *(u32x4*)(dst + 48) = z; }
        }
    }
}

DI void p2_mla_kv(const Params& p, int layer, int item, char* lds) {
    const int mt = item >> 2, head = item & 3, m0 = mt * 128;
    const bf16_t* proj = (const bf16_t*)(p.ws + OFF_PROJ);
    const bf16_t* A = proj + (size_t)m0 * PJ + C_CKV;
    float* rsd = (float*)(lds + RS_OFF);
    __syncthreads();
    rows_rstd(A, PJ, 128, rsd);
    const int lane = ltid() & 63, w = ltid() >> 6, wr = w >> 1, wc = w & 1, r = lane & 31, h = lane >> 5;
    f32x16 acc[2][2];
    gemm128<2>(A, PJ, (const bf16_t*)(p.ws + OFF_WUKV) + (size_t)layer * 512 * 128 + (size_t)head * 128 * 128, 128, 128, lds, acc, wc == 0);
    const int b = tok_b(m0), pos_base = m0 - b * P;
    unsigned char* Km = (unsigned char*)(p.ws + OFF_KM) + (size_t)(b * 4 + head) * P * 128;
    unsigned char* Vt = (unsigned char*)(p.ws + OFF_VTM) + (size_t)(b * 4 + head) * 64 * P;
    if (wc == 0) {
#pragma unroll
        for (int i = 0; i < 2; ++i) {
            const int tl = wr * 64 + i * 32 + r;
            const float rs = rsd[tl];
            unsigned char* dst = Km + (size_t)(pos_base + tl) * 128;
#pragma unroll
            for (int j = 0; j < 2; ++j)
#pragma unroll
                for (int g = 0; g < 4; ++g) {
                    int pk = __builtin_amdgcn_cvt_pk_fp8_f32(acc[i][j][4 * g] * rs, acc[i][j][4 * g + 1] * rs, 0, false);
                    pk = __builtin_amdgcn_cvt_pk_fp8_f32(acc[i][j][4 * g + 2] * rs, acc[i][j][4 * g + 3] * rs, pk, true);
                    *(int*)(dst + j * 32 + 8 * g + 4 * h) = pk;
                }
        }
    } else {
#pragma unroll
        for (int i = 0; i < 2; ++i)
#pragma unroll
            for (int j = 0; j < 2; ++j) {
                const int dv = j * 32 + r;
#pragma unroll
                for (int g = 0; g < 4; ++g) {
                    const int tl = wr * 64 + i * 32 + 8 * g + 4 * h;
                    const f32x4 rv = *(const f32x4*)(rsd + tl);
                    int pk = __builtin_amdgcn_cvt_pk_fp8_f32(acc[i][j][4 * g] * rv[0], acc[i][j][4 * g + 1] * rv[1], 0, false);
                    pk = __builtin_amdgcn_cvt_pk_fp8_f32(acc[i][j][4 * g + 2] * rv[2], acc[i][j][4 * g + 3] * rv[3], pk, true);
                    *(int*)(Vt + (size_t)dv * P + pos_base + wr * 64 + 32 * h + 16 * i + 4 * g) = pk;
                }
            }
    }
    {
        const int tl = ltid() >> 1, part = ltid() & 1;
        const int pos = pos_base + tl;
        const bf16_t* src = proj + (size_t)(m0 + tl) * PJ + C_KR + 16 * part;
        const u32x4 a = *(const u32x4*)src, bq = *(const u32x4*)(src + 8);
        float x1[8], x2[8];
#pragma unroll
        for (int e = 0; e < 4; ++e) { x1[2 * e] = bflo(a[e]); x1[2 * e + 1] = bfhi(a[e]); x2[2 * e] = bflo(bq[e]); x2[2 * e + 1] = bfhi(bq[e]); }
        if (pos >= CTXL) {
            const int t = pos - CTXL;
            const float fp = part == 0 ? (float)(t >> 6) : (float)(t & 63);
#pragma unroll
            for (int e = 0; e < 8; ++e) {
                float s, c;
                sincos_cw(fp * INV8[e], s, c);
                const float u1 = x1[e], u2 = x2[e];
                x1[e] = u1 * c - u2 * s; x2[e] = u1 * s + u2 * c;
            }
        }
        u32x4 o;
#pragma unroll
        for (int e = 0; e < 2; ++e) {
            int a_ = __builtin_amdgcn_cvt_pk_fp8_f32(x1[4 * e], x1[4 * e + 1], 0, false); a_ = __builtin_amdgcn_cvt_pk_fp8_f32(x1[4 * e + 2], x1[4 * e + 3], a_, true);
            int b_ = __builtin_amdgcn_cvt_pk_fp8_f32(x2[4 * e], x2[4 * e + 1], 0, false); b_ = __builtin_amdgcn_cvt_pk_fp8_f32(x2[4 * e + 2], x2[4 * e + 3], b_, true);
            o[e] = (unsigned)a_; o[2 + e] = (unsigned)b_;
        }
        unsigned char* dst = Km + (size_t)pos * 128 + 64 + 16 * part;
        *(u32x4*)dst = o;
        const u32x4 z = {part == 0 ? 0x3838u : 0u, 0u, 0u, 0u};
        *(u32x4*)(dst + 32) = z;
    }
}

DI void p2_rope(const Params& p, int item) {
    const int gid = item * 256 + ltid();
    const int tokl = gid / 12, rem = gid % 12, slot = rem >> 1, part = rem & 1;
    const int b = tokl / T, t = tokl % T;
    const int n = b * P + CTXL + t;
    bf16_t* base = (bf16_t*)(p.ws + OFF_PROJ) + (size_t)n * PJ + (slot < 4 ? C_SWQ + slot * 64 : C_SWK + (slot - 4) * 64) + part * 32;
    const float fp = part == 0 ? (float)(t >> 6) : (float)(t & 63);
    u32x4 a0 = *(const u32x4*)base, a1 = *(const u32x4*)(base + 8), b0 = *(const u32x4*)(base + 16), b1 = *(const u32x4*)(base + 24);
    float x1[16], x2[16];
#pragma unroll
    for (int e = 0; e < 4; ++e) {
        x1[2 * e] = bflo(a0[e]); x1[2 * e + 1] = bfhi(a0[e]); x1[8 + 2 * e] = bflo(a1[e]); x1[8 + 2 * e + 1] = bfhi(a1[e]);
        x2[2 * e] = bflo(b0[e]); x2[2 * e + 1] = bfhi(b0[e]); x2[8 + 2 * e] = bflo(b1[e]); x2[8 + 2 * e + 1] = bfhi(b1[e]);
    }
#pragma unroll
    for (int e = 0; e < 16; ++e) {
        float s, c;
        sincos_cw(fp * INV16[e], s, c);
        const float u1 = x1[e], u2 = x2[e];
        x1[e] = u1 * c - u2 * s; x2[e] = u1 * s + u2 * c;
    }
#pragma unroll
    for (int e = 0; e < 4; ++e) {
        a0[e] = pk2(x1[2 * e], x1[2 * e + 1]); a1[e] = pk2(x1[8 + 2 * e], x1[8 + 2 * e + 1]);
        b0[e] = pk2(x2[2 * e], x2[2 * e + 1]); b1[e] = pk2(x2[8 + 2 * e], x2[8 + 2 * e + 1]);
    }
    *(u32x4*)base = a0; *(u32x4*)(base + 8) = a1; *(u32x4*)(base + 16) = b0; *(u32x4*)(base + 24) = b1;
}
DI int ml_order(int dir, int i) { return dir == 0 ? i : (i < 4 ? 3 - i : 263 - i); }
constexpr int ML_LD = 72;

DI void p2_mlstm(const Params& p, int layer, int item, char* lds) {
    const int b = item / (4 * NCH), hh = (item / NCH) & 3, c = item % NCH;
    const int tid = ltid(), lane = tid & 63, w = tid >> 6, r = lane & 31, h = lane >> 5;
    const int pos0 = c * 64, seg_lo = c < 4 ? 0 : CTXL, seg_hi = c < 4 ? CTXL : P;
    const int nbase = b * P + pos0;
    bf16_t* KT = (bf16_t*)lds;
    bf16_t* VWf = KT + 64 * ML_LD;
    bf16_t* VWb = VWf + 64 * ML_LD;
    float* cw = (float*)(VWb + 64 * ML_LD);
    float* wkf = cw + 640;
    float* wkb = wkf + 64;
    const bf16_t* proj = (const bf16_t*)(p.ws + OFF_PROJ);
    __syncthreads();
    for (int i = tid; i < 640; i += 256) {
        const int j = i >> 7, cc = i & 127;
        cw[i] = p.in[10][(size_t)layer * 5 * 512 + j * 512 + (cc < 64 ? hh * 64 + cc : 256 + hh * 64 + (cc - 64))];
    }
    if (w == 0) {
        const int n = nbase + lane;
        const float* gp = (const float*)(p.ws + OFF_GATES) + (size_t)n * 16;
        const float* gb = p.in[11] + layer * 16;
        const float i_f = gp[hh] + gb[hh], f_f = gp[4 + hh] + gb[4 + hh], i_b = gp[8 + hh] + gb[8 + hh], f_b = gp[12 + hh] + gb[12 + hh];
        float bf_ = logsigmoidf_(f_f), bb_ = logsigmoidf_(f_b);
#pragma unroll
        for (int o = 1; o < 64; o <<= 1) {
            const float uf = shfrom(bf_, lane >= o ? lane - o : lane), ub = shfrom(bb_, lane + o < 64 ? lane + o : lane);
            if (lane >= o) bf_ += uf;
            if (lane + o < 64) bb_ += ub;
        }
        const float Ff = shfrom(bf_, 63), Fb = shfrom(bb_, 0);
        const float gf = Ff - bf_ + i_f, gbw = Fb - bb_ + i_b;
        float mgf = gf, mgb = gbw;
#pragma unroll
        for (int o = 32; o > 0; o >>= 1) { mgf = fmaxf(mgf, shx(mgf, o, lane)); mgb = fmaxf(mgb, shx(mgb, o, lane)); }
        wkf[lane] = fexp(gf - mgf); wkb[lane] = fexp(gbw - mgb);
        float* GB = (float*)(p.ws + OFF_GB);
        f32x2 v0 = {bf_, i_f}, v1 = {bb_, i_b};
        *(f32x2*)(GB + ((size_t)(0 * NTOK + n) * 4 + hh) * 2) = v0;
        *(f32x2*)(GB + ((size_t)(1 * NTOK + n) * 4 + hh) * 2) = v1;
        if (lane == 0) {
            float* META = (float*)(p.ws + OFF_META);
            const int ch0 = 0 * 8 + b * 4 + hh, ch1 = 8 + b * 4 + hh;
            META[((size_t)ch0 * NCH + c) * 4 + 0] = Ff; META[((size_t)ch0 * NCH + c) * 4 + 1] = mgf;
            META[((size_t)ch1 * NCH + c) * 4 + 0] = Fb; META[((size_t)ch1 * NCH + c) * 4 + 1] = mgb;
        }
    }
    __syncthreads();
    bf16_t* QC = (bf16_t*)(p.ws + OFF_QC);
    bf16_t* KC = (bf16_t*)(p.ws + OFF_KC);
#pragma unroll
    for (int i = 0; i < 4; ++i) {
        const int u = tid + 256 * i, s = u & 63, grp = u >> 6;
        const int col = (grp < 8 ? C_MLQ + hh * 64 + grp * 8 : C_MLK + hh * 64 + (grp - 8) * 8);
        const int cwo = (grp < 8 ? grp * 8 : 64 + (grp - 8) * 8);
        float a[8];
#pragma unroll
        for (int e = 0; e < 8; ++e) a[e] = 0.f;
#pragma unroll
        for (int j = 0; j < 5; ++j) {
            const int pos = pos0 + s + j - 2;
            if (pos >= seg_lo && pos < seg_hi) {
                const u32x4 v = *(const u32x4*)(proj + (size_t)(b * P + pos) * PJ + col);
#pragma unroll
                for (int e = 0; e < 4; ++e) { a[2 * e] = fmaf(bflo(v[e]), cw[j * 128 + cwo + 2 * e], a[2 * e]); a[2 * e + 1] = fmaf(bfhi(v[e]), cw[j * 128 + cwo + 2 * e + 1], a[2 * e + 1]); }
            }
        }
#pragma unroll
        for (int e = 0; e < 8; ++e) a[e] = siluf(a[e]) * (grp < 8 ? 0.125f : 1.f);
        u32x4 o; o[0] = pk2(a[0], a[1]); o[1] = pk2(a[2], a[3]); o[2] = pk2(a[4], a[5]); o[3] = pk2(a[6], a[7]);
        if (grp < 8) *(u32x4*)(QC + (size_t)(nbase + s) * 256 + hh * 64 + grp * 8) = o;
        else {
            *(u32x4*)(KC + (size_t)(nbase + s) * 256 + hh * 64 + (grp - 8) * 8) = o;
#pragma unroll
            for (int e = 0; e < 4; ++e) { KT[((grp - 8) * 8 + 2 * e) * ML_LD + s] = (bf16_t)(o[e] & 0xffffu); KT[((grp - 8) * 8 + 2 * e + 1) * ML_LD + s] = (bf16_t)(o[e] >> 16); }
        }
    }
#pragma unroll
    for (int i = 0; i < 2; ++i) {
        const int u = tid + 256 * i, s = u & 63, grp = u >> 6;
        const u32x4 v = *(const u32x4*)(proj + (size_t)(nbase + s) * PJ + C_MLV + hh * 64 + grp * 8);
        const float wf = wkf[s], wb = wkb[s];
#pragma unroll
        for (int e = 0; e < 4; ++e) {
            const float x = bflo(v[e]), y = bfhi(v[e]);
            VWf[(grp * 8 + 2 * e) * ML_LD + s] = f2bf(x * wf); VWf[(grp * 8 + 2 * e + 1) * ML_LD + s] = f2bf(y * wf);
            VWb[(grp * 8 + 2 * e) * ML_LD + s] = f2bf(x * wb); VWb[(grp * 8 + 2 * e + 1) * ML_LD + s] = f2bf(y * wb);
        }
    }
    __syncthreads();
    {
        const int dir = w >> 1, dkt = w & 1;
        const bf16_t* VW = dir ? VWb : VWf;
        f32x16 u0, u1;
#pragma unroll
        for (int e = 0; e < 16; ++e) { u0[e] = 0.f; u1[e] = 0.f; }
#pragma unroll
        for (int ks = 0; ks < 4; ++ks) {
            const bf16x8 a = *(const bf16x8*)(KT + (dkt * 32 + r) * ML_LD + ks * 16 + 8 * h);
            const bf16x8 b0 = *(const bf16x8*)(VW + (r) * ML_LD + ks * 16 + 8 * h);
            const bf16x8 b1 = *(const bf16x8*)(VW + (32 + r) * ML_LD + ks * 16 + 8 * h);
            u0 = MFMA32(a, b0, u0);
            u1 = MFMA32(a, b1, u1);
        }
        const int chain = dir * 8 + b * 4 + hh;
        bf16_t* UB = (bf16_t*)(p.ws + OFF_UB) + ((size_t)chain * NCH + c) * 4096;
#pragma unroll
        for (int g = 0; g < 4; ++g) {
            u32x2 o; o[0] = pk2(u0[4 * g], u0[4 * g + 1]); o[1] = pk2(u0[4 * g + 2], u0[4 * g + 3]);
            *(u32x2*)(UB + (size_t)(r) * 64 + dkt * 32 + 8 * g + 4 * h) = o;
            u32x2 q; q[0] = pk2(u1[4 * g], u1[4 * g + 1]); q[1] = pk2(u1[4 * g + 2], u1[4 * g + 3]);
            *(u32x2*)(UB + (size_t)(32 + r) * 64 + dkt * 32 + 8 * g + 4 * h) = q;
        }
    }
    if (tid < 128) {
        const int dir = tid >> 6, dk = tid & 63;
        const float* wk = dir ? wkb : wkf;
        float s = 0.f;
#pragma unroll 8
        for (int t = 0; t < 64; ++t) s = fmaf(wk[t], bf2f(KT[dk * ML_LD + t]), s);
        const int chain = dir * 8 + b * 4 + hh;
        ((float*)(p.ws + OFF_UN))[((size_t)chain * NCH + c) * 64 + dk] = s;
    }
}

constexpr int P3_SCAN = 16 * 2080 / 256;
DI void p3_scan(const Params& p, int item) {
    const int gid = item * 256 + ltid();
    const int chain = gid / 2080, e2 = gid % 2080, dir = chain >> 3;
    const float* META = (const float*)(p.ws + OFF_META) + (size_t)chain * NCH * 4;
    float* METAw = (float*)(p.ws + OFF_META) + (size_t)chain * NCH * 4;
    const bool is_mat = e2 < 2048;
    unsigned* UBm = (unsigned*)((bf16_t*)(p.ws + OFF_UB) + (size_t)chain * NCH * 4096) + (is_mat ? e2 : 0);
    f32x2* UNm = (f32x2*)((float*)(p.ws + OFF_UN) + (size_t)chain * NCH * 64) + (is_mat ? 0 : e2 - 2048);
    float s0 = 0.f, s1 = 0.f, m = 0.f;
    constexpr int SB = 4;
    for (int i0 = 0; i0 < NCH; i0 += SB) {
        float u0[SB], u1[SB], F[SB], mg[SB]; int cc[SB];
#pragma unroll
        for (int k = 0; k < SB; ++k) {
            cc[k] = ml_order(dir, i0 + k);
            F[k] = META[cc[k] * 4 + 0]; mg[k] = META[cc[k] * 4 + 1];
            if (is_mat) { const unsigned v = UBm[(size_t)cc[k] * 2048]; u0[k] = bflo(v); u1[k] = bfhi(v); }
            else { const f32x2 v = UNm[(size_t)cc[k] * 32]; u0[k] = v[0]; u1[k] = v[1]; }
        }
#pragma unroll
        for (int k = 0; k < SB; ++k) {
            if (is_mat) UBm[(size_t)cc[k] * 2048] = pk2(s0, s1);
            else { f32x2 v = {s0, s1}; UNm[(size_t)cc[k] * 32] = v; }
            if (e2 == 0) METAw[cc[k] * 4 + 2] = m;
            const float mn = fmaxf(F[k] + m, mg[k]);
            const float dec = fexp(F[k] + m - mn), sc = fexp(mg[k] - mn);
            s0 = fmaf(dec, s0, sc * u0[k]); s1 = fmaf(dec, s1, sc * u1[k]);
            m = mn;
        }
    }
}

constexpr int P4_ITEMS = NB * 4 * NCH;
DI void p4_mlstm_out(const Params& p, int layer, int item, char* lds) {
    const int b = item / (4 * NCH), hh = (item / NCH) & 3, c = item % NCH;
    const int tid = ltid(), lane = tid & 63, w = tid >> 6, r = lane & 31, h = lane >> 5;
    const int nbase = b * P + c * 64;
    bf16_t* Qs = (bf16_t*)lds;
    bf16_t* Ks = Qs + 64 * ML_LD;
    bf16_t* Cs = Ks + 64 * ML_LD;
    bf16_t* Vt = Cs + 2 * 64 * ML_LD;
    float* nv = (float*)(Vt + 64 * 68);
    float* bg = nv + 128;
    float* dd = bg + 128;
    float* mp = dd + 128;
    float* X = mp + 4;
    const bf16_t* proj = (const bf16_t*)(p.ws + OFF_PROJ);
    __syncthreads();
    {
        const bf16_t* QC = (const bf16_t*)(p.ws + OFF_QC) + (size_t)nbase * 256 + hh * 64;
        const bf16_t* KC = (const bf16_t*)(p.ws + OFF_KC) + (size_t)nbase * 256 + hh * 64;
#pragma unroll
        for (int i = 0; i < 2; ++i) {
            const int cidx = tid + 256 * i, row = cidx >> 3, kc = (cidx & 7) * 8;
            *(u32x4*)(Qs + row * ML_LD + kc) = *(const u32x4*)(QC + (size_t)row * 256 + kc);
            *(u32x4*)(Ks + row * ML_LD + kc) = *(const u32x4*)(KC + (size_t)row * 256 + kc);
#pragma unroll
            for (int d = 0; d < 2; ++d) {
                const int chain = d * 8 + b * 4 + hh;
                const bf16_t* UB = (const bf16_t*)(p.ws + OFF_UB) + ((size_t)chain * NCH + c) * 4096;
                *(u32x4*)(Cs + (d * 64 + row) * ML_LD + kc) = *(const u32x4*)(UB + row * 64 + kc);
            }
            const int key = tid & 63, vc = (tid >> 6) + 4 * i;
            const u32x4 v = *(const u32x4*)(proj + (size_t)(nbase + key) * PJ + C_MLV + hh * 64 + vc * 8);
#pragma unroll
            for (int e = 0; e < 4; ++e) { Vt[(vc * 8 + 2 * e) * 68 + key] = (bf16_t)(v[e] & 0xffffu); Vt[(vc * 8 + 2 * e + 1) * 68 + key] = (bf16_t)(v[e] >> 16); }
        }
        if (tid < 128) {
            const int d = tid >> 6, s = tid & 63, chain = d * 8 + b * 4 + hh;
            nv[tid] = ((const float*)(p.ws + OFF_UN))[((size_t)chain * NCH + c) * 64 + s];
            const f32x2 g = *(const f32x2*)((const float*)(p.ws + OFF_GB) + ((size_t)(d * NTOK + nbase + s) * 4 + hh) * 2);
            bg[tid] = g[0]; dd[tid] = g[1] - g[0];
            if (s == 0) mp[d] = ((const float*)(p.ws + OFF_META))[((size_t)chain * NCH + c) * 4 + 2];
        }
    }
    __syncthreads();
    const int dir = w >> 1, tt = w & 1;
    const int t = tt * 32 + r;
    const float bt = bg[dir * 64 + t], mprev = mp[dir];
    bf16x8 qf[4];
#pragma unroll
    for (int ks = 0; ks < 4; ++ks) qf[ks] = *(const bf16x8*)(Qs + t * ML_LD + ks * 16 + 8 * h);
    f32x16 sa[2];
    float mt = bt + mprev;
#pragma unroll
    for (int st = 0; st < 2; ++st) {
        const bool skip = dir == 0 ? (st > tt) : (st < tt);
#pragma unroll
        for (int e = 0; e < 16; ++e) sa[st][e] = 0.f;
        if (!skip) {
#pragma unroll
            for (int ks = 0; ks < 4; ++ks) {
                const bf16x8 kf = *(const bf16x8*)(Ks + (st * 32 + r) * ML_LD + ks * 16 + 8 * h);
                sa[st] = MFMA32(kf, qf[ks], sa[st]);
            }
        }
    }
    float dl[2][16];
#pragma unroll
    for (int st = 0; st < 2; ++st)
#pragma unroll
        for (int e = 0; e < 16; ++e) {
            const int s = st * 32 + crow(e, h);
            const bool valid = dir == 0 ? (s <= t) : (s >= t);
            const float v = valid ? bt + dd[dir * 64 + s] : -1e30f;
            dl[st][e] = v;
            mt = fmaxf(mt, v);
        }
    mt = fmaxf(mt, shx(mt, 32, lane));
    float rsum = 0.f;
#pragma unroll
    for (int st = 0; st < 2; ++st)
#pragma unroll
        for (int e = 0; e < 16; ++e) { const float wgt = fexp(dl[st][e] - mt); sa[st][e] *= wgt; rsum += sa[st][e]; }
    rsum += shx(rsum, 32, lane);
    const float at = fexp(bt + mprev - mt);
    float qn = 0.f;
#pragma unroll 8
    for (int k = 0; k < 32; ++k) qn = fmaf(bf2f(Qs[t * ML_LD + 32 * h + k]), nv[dir * 64 + 32 * h + k], qn);
    qn += shx(qn, 32, lane);
    bf16x8 pf[4];
    {
        u32x4 tq;
#pragma unroll
        for (int st = 0; st < 2; ++st) {
            tq[0] = pk2(sa[st][0], sa[st][1]); tq[1] = pk2(sa[st][2], sa[st][3]); tq[2] = pk2(sa[st][4], sa[st][5]); tq[3] = pk2(sa[st][6], sa[st][7]); pf[2 * st] = __builtin_bit_cast(bf16x8, tq);
            tq[0] = pk2(sa[st][8], sa[st][9]); tq[1] = pk2(sa[st][10], sa[st][11]); tq[2] = pk2(sa[st][12], sa[st][13]); tq[3] = pk2(sa[st][14], sa[st][15]); pf[2 * st + 1] = __builtin_bit_cast(bf16x8, tq);
        }
    }
    f32x16 on[2], oi[2];
#pragma unroll
    for (int dv = 0; dv < 2; ++dv) {
#pragma unroll
        for (int e = 0; e < 16; ++e) { on[dv][e] = 0.f; oi[dv][e] = 0.f; }
#pragma unroll
        for (int st = 0; st < 4; ++st) {
            const s16x4 lo = *(const s16x4*)(Vt + (dv * 32 + r) * 68 + 16 * st + 4 * h), hi = *(const s16x4*)(Vt + (dv * 32 + r) * 68 + 16 * st + 8 + 4 * h);
            const bf16x8 vf = __builtin_shufflevector(lo, hi, 0, 1, 2, 3, 4, 5, 6, 7);
            on[dv] = MFMA32(vf, pf[st], on[dv]);
        }
#pragma unroll
        for (int ks = 0; ks < 4; ++ks) {
            const bf16x8 cf = *(const bf16x8*)(Cs + (dir * 64 + dv * 32 + r) * ML_LD + ks * 16 + 8 * h);
            oi[dv] = MFMA32(cf, qf[ks], oi[dv]);
        }
    }
    const float den = rsum + at * qn;
    const float invd = 1.f / fmaxf(fabsf(den), fexp(-mt));
    if (dir == 1) {
#pragma unroll
        for (int dv = 0; dv < 2; ++dv)
#pragma unroll
            for (int e = 0; e < 16; ++e) X[t * 65 + dv * 32 + crow(e, h)] = (on[dv][e] + at * oi[dv][e]) * invd;
    }
    __syncthreads();
    if (dir == 0) {
        const int n = nbase + t;
        bf16_t* y = (bf16_t*)(p.ws + OFF_ACT) + (size_t)n * D + 256 + hh * 64;
        const bf16_t* mo = proj + (size_t)n * PJ + C_MLO + hh * 64;
#pragma unroll
        for (int dv = 0; dv < 2; ++dv)
#pragma unroll
            for (int g = 0; g < 4; ++g) {
                const int d0 = dv * 32 + 8 * g + 4 * h;
                const u32x2 ov = *(const u32x2*)(mo + d0);
                const float og[4] = {bflo(ov[0]), bfhi(ov[0]), bflo(ov[1]), bfhi(ov[1])};
                float res[4];
#pragma unroll
                for (int e = 0; e < 4; ++e) res[e] = ((on[dv][4 * g + e] + at * oi[dv][4 * g + e]) * invd + X[t * 65 + d0 + e]) * sigmoidf_(og[e]);
                u32x2 o; o[0] = pk2(res[0], res[1]); o[1] = pk2(res[2], res[3]);
                *(u32x2*)(y + d0) = o;
            }
    }
}
DI unsigned f2ord(float f) { const unsigned u = __float_as_uint(f); return (u & 0x80000000u) ? ~u : (u | 0x80000000u); }
DI float ord2f(unsigned u) { return __uint_as_float((u & 0x80000000u) ? (u & 0x7fffffffu) : ~u); }
DI void cex(unsigned& a, unsigned& b, bool desc) { const unsigned mx = a > b ? a : b, mn = a > b ? b : a; a = desc ? mx : mn; b = desc ? mn : mx; }

DI void sort_runs16(unsigned (&k)[64]) {
#pragma unroll
    for (int size = 2; size <= 16; size <<= 1)
#pragma unroll
        for (int stride = size >> 1; stride > 0; stride >>= 1)
#pragma unroll
            for (int i = 0; i < 64; ++i) {
                const int j = i ^ stride;
                if (j > i) cex(k[i], k[j], (i & size) == 0);
            }
}
DI void merge16(unsigned (&a)[16], bool desc) {
#pragma unroll
    for (int stride = 8; stride > 0; stride >>= 1)
#pragma unroll
        for (int i = 0; i < 16; ++i) {
            const int j = i ^ stride;
            if (j > i) cex(a[i], a[j], desc);
        }
}
DI void top16_of_64(unsigned (&k)[64], unsigned (&out)[16]) {
    sort_runs16(k);
    unsigned a[16], b[16];
#pragma unroll
    for (int i = 0; i < 16; ++i) { a[i] = k[i] > k[16 + i] ? k[i] : k[16 + i]; b[i] = k[32 + i] > k[48 + i] ? k[32 + i] : k[48 + i]; }
    merge16(a, true);
    merge16(b, false);
#pragma unroll
    for (int i = 0; i < 16; ++i) out[i] = a[i] > b[i] ? a[i] : b[i];
    merge16(out, true);
}

constexpr int P7_ITEMS = (NTOK / 128) * 8;
constexpr int QY_LD = 136;
constexpr int P7_LST = G_LDS;
constexpr int P7_TAB = G_LDS + 4096;

DI void p7_item(const Params& p, int layer, int item, char* lds) {
    const int mt = item >> 3, head = item & 7, m0 = mt * 128;
#define P7_IDS const int tid = ltid(), lane = tid & 63, w = tid >> 6, wr = w >> 1, wc = w & 1, r = lane & 31, h = lane >> 5; (void)wr; (void)wc; (void)lane; (void)r; (void)h;
    unsigned char* lst = (unsigned char*)(lds + P7_LST);
    unsigned char* tab = (unsigned char*)(lds + P7_TAB);
    bf16_t* Qy = (bf16_t*)lds;
    bf16_t* Ky = Qy + 128 * QY_LD;
    unsigned* LSTG = (unsigned*)(p.ws + OFF_LSTG);
    __syncthreads();
    { P7_IDS
    if (tid < 64) {
        int cid = 0; unsigned char v = 0;
        for (int i = 0; i < 16; ++i) { const int nj = 16 / (i + 1); if (tid >= cid && tid < cid + nj) v = (unsigned char)((i << 4) | (tid - cid)); cid += nj; }
        tab[tid] = v;
    } }
#pragma unroll 1
    for (int pp = 0; pp < 2; ++pp) {
        const int hp = head * 2 + pp;
        __builtin_amdgcn_sched_barrier(0);
        i32x16 acc[2][2];
        gemm128_i8((const unsigned char*)(p.ws + OFF_XQ) + (size_t)m0 * D, D, (const unsigned char*)(p.ws + OFF_WQ) + (size_t)layer * 2048 * D + (size_t)hp * 128 * D, D, D, lds, acc);
        __builtin_amdgcn_sched_barrier(0);
        P7_IDS
#pragma unroll
        for (int i = 0; i < 2; ++i)
#pragma unroll
            for (int j = 0; j < 2; ++j)
#pragma unroll
                for (int g = 0; g < 4; ++g) {
                    const float sa = ((const float*)(p.ws + OFF_SXQ))[m0 + wr * 64 + i * 32 + r];
                    const f32x4 sb = *(const f32x4*)((const float*)(p.ws + OFF_SWQ) + layer * 2048 + hp * 128 + wc * 64 + j * 32 + 8 * g + 4 * h);
                    u32x2 o; o[0] = pk2((float)acc[i][j][4 * g] * (sa * sb[0]), (float)acc[i][j][4 * g + 1] * (sa * sb[1])); o[1] = pk2((float)acc[i][j][4 * g + 2] * (sa * sb[2]), (float)acc[i][j][4 * g + 3] * (sa * sb[3]));
                    *(u32x2*)(Qy + (wr * 64 + i * 32 + r) * QY_LD + wc * 64 + j * 32 + 8 * g + 4 * h) = o;
                }
        {
            const bf16_t* keys = (const bf16_t*)(p.ws + OFF_KEYS) + (size_t)layer * 262144 + (size_t)hp * 16384;
#pragma unroll
            for (int i = 0; i < 8; ++i) {
                const int c = tid + 256 * i, row = c >> 4, kc = (c & 15) * 8;
                *(u32x4*)(Ky + row * QY_LD + kc) = *(const u32x4*)(keys + row * 128 + kc);
            }
        }
        __syncthreads();
        f32x16 sc[4];
#pragma unroll
        for (int nt = 0; nt < 4; ++nt)
#pragma unroll
            for (int e = 0; e < 16; ++e) sc[nt][e] = 0.f;
#pragma unroll
        for (int ks = 0; ks < 8; ++ks) {
            const bf16x8 qf = *(const bf16x8*)(Qy + (w * 32 + r) * QY_LD + ks * 16 + 8 * h);
#pragma unroll
            for (int nt = 0; nt < 4; ++nt) {
                const bf16x8 kf = *(const bf16x8*)(Ky + (nt * 32 + r) * QY_LD + ks * 16 + 8 * h);
                sc[nt] = MFMA32(kf, qf, sc[nt]);
            }
        }
        __builtin_amdgcn_sched_barrier(0);
        unsigned k[64];
#pragma unroll
        for (int nt = 0; nt < 4; ++nt)
#pragma unroll
            for (int e = 0; e < 16; ++e) k[nt * 16 + e] = (f2ord(sc[nt][e]) & ~127u) | (unsigned)(127 - (nt * 32 + crow(e, h)));
        unsigned R[16];
        top16_of_64(k, R);
        __builtin_amdgcn_sched_barrier(0);
        unsigned F[16];
#pragma unroll
        for (int i = 0; i < 16; ++i) { const unsigned o = shxu(R[15 - i], 32, lane); F[i] = R[i] > o ? R[i] : o; }
        merge16(F, true);
        if (h == 0) {
#pragma unroll
            for (int i = 0; i < 16; ++i) lst[(w * 32 + r) * 32 + pp * 16 + i] = (unsigned char)(127 - (F[i] & 127u));
        }
        if (h == 0) {
            unsigned* dst = LSTG + ((size_t)(m0 + w * 32 + r) * 16 + hp) * 16;
#pragma unroll
            for (int q = 0; q < 4; ++q) { u32x4 v = {F[4 * q], F[4 * q + 1], F[4 * q + 2], F[4 * q + 3]}; *(u32x4*)(dst + 4 * q) = v; }
        }
    }
    asm volatile("s_waitcnt vmcnt(0)" ::: "memory");
    __syncthreads();
    P7_IDS
    unsigned L0[16], L1[16];
    {
        const unsigned* src = LSTG + ((size_t)(m0 + w * 32 + r) * 16 + head * 2) * 16;
#pragma unroll
        for (int q = 0; q < 4; ++q) {
            const u32x4 a = *(const u32x4*)(src + 4 * q), b = *(const u32x4*)(src + 16 + 4 * q);
#pragma unroll
            for (int e = 0; e < 4; ++e) { L0[4 * q + e] = a[e]; L1[4 * q + e] = b[e]; }
        }
    }
    __builtin_amdgcn_sched_barrier(0);
    float s0[16], s1[16];
#pragma unroll
    for (int i = 0; i < 16; ++i) { s0[i] = ord2f(L0[i] & ~127u); s1[i] = ord2f(L1[i] & ~127u); }
    unsigned ck[64];
    {
        int cid = 0;
#pragma unroll
        for (int i = 0; i < 16; ++i)
#pragma unroll
            for (int j = 0; j < 16; ++j)
                if ((i + 1) * (j + 1) <= 16) { ck[cid] = (f2ord(s0[i] + s1[j]) & ~63u) | (unsigned)(63 - cid); ++cid; }
#pragma unroll
        for (int q = 50; q < 64; ++q) ck[q] = 0u;
    }
    __builtin_amdgcn_sched_barrier(0);
    unsigned W[16];
    top16_of_64(ck, W);
    __builtin_amdgcn_sched_barrier(0);
    __syncthreads();
    const int tl = w * 32 + r, tok = m0 + tl;
    float fs[16]; int ei[16];
#pragma unroll
    for (int q = 0; q < 16; ++q) {
        const int cid = 63 - (int)(W[q] & 63u);
        const int ij = tab[cid];
        const int i0 = lst[tl * 32 + (ij >> 4)], i1 = lst[tl * 32 + 16 + (ij & 15)];
        ei[q] = i0 * 128 + i1;
        fs[q] = ord2f(W[q] & ~63u);
    }
    float sum = 0.f;
#pragma unroll
    for (int q = 0; q < 16; ++q) { fs[q] = fexp(fs[q] - ord2f(W[0] & ~63u)); sum += fs[q]; }
    const float inv = 1.f / sum;
    const float* SU = (const float*)(p.ws + OFF_PSC) + (size_t)(layer * 2) * NEXP;
    const float* SV = SU + NEXP;
    if (h == 0) {
        int* dst = (int*)(p.ws + OFF_EIDX) + (size_t)tok * 128;
        float* dsu = (float*)(p.ws + OFF_SUE) + (size_t)tok * 128 + head * 16;
#pragma unroll
        for (int q = 0; q < 16; ++q) dst[(q & 7) * 16 + head * 2 + (q >> 3)] = ei[q];
#pragma unroll
        for (int q = 0; q < 4; ++q) { f32x4 u = {SU[ei[4 * q]], SU[ei[4 * q + 1]], SU[ei[4 * q + 2]], SU[ei[4 * q + 3]]}; *(f32x4*)(dsu + 4 * q) = u; }
    } else {
        float* dst = (float*)(p.ws + OFF_GATE) + (size_t)tok * 128 + head * 16;
#pragma unroll
        for (int q = 0; q < 4; ++q) { f32x4 v = {fs[4 * q] * inv * SV[ei[4 * q]], fs[4 * q + 1] * inv * SV[ei[4 * q + 1]], fs[4 * q + 2] * inv * SV[ei[4 * q + 2]], fs[4 * q + 3] * inv * SV[ei[4 * q + 3]]}; *(f32x4*)(dst + 4 * q) = v; }
    }
}
#undef P7_IDS
DI float gelu_exact(float v) { return 0.5f * v * (1.f + erff(v * 0.70710678118654752f)); }
constexpr int P8_TPW = 16;
constexpr int P8_GRABS = NTOK / (4 * P8_TPW);
constexpr size_t SLICE_BYTES = (size_t)NEXP * 128;

DI int p8_next(unsigned* ctr8, volatile int* slot, int& slice, int layer) {
    __syncthreads();
    if (threadIdx.x == 0) {
        int s = slice, g = -1;
        for (int tries = 0; tries < 8; ++tries) {
            const int v = (int)atomicAdd(&ctr8[s], 1u);
            if (v < (layer ? 512 : P8_GRABS)) { g = layer ? ((v >> 8) * 260 + 4 + (v & 255)) : v; break; }
            s = (s + 1) & 7;
        }
        slot[0] = g; slot[1] = s;
    }
    __syncthreads();
    slice = __builtin_amdgcn_readfirstlane(slot[1]);
    return __builtin_amdgcn_readfirstlane(slot[0]);
}

typedef int i32x4b __attribute__((ext_vector_type(4)));
#define P8_ISSUE_M(ur_, ev_, base_, m_)                                                                      \
    { _Pragma("unroll") for (int b = 0; b < 16; ++b) {                                                       \
          const int e_ = ev_[b >> 2][b & 3];                                                                 \
          ur_[b] = *(const u32x4*)((base_) + (unsigned)(((e_ & (m_)) << 7) + lo16_)); } }
#define P8_ISSUE(ur_, ev_, base_) P8_ISSUE_M(ur_, ev_, base_, 0x7fffffff)
#define P8_LOADE(ev_, n_) { const i32x4b* ep_ = (const i32x4b*)(EI + (size_t)(n_) * 128 + eg * 16); ev_[0] = ep_[0]; ev_[1] = ep_[1]; ev_[2] = ep_[2]; ev_[3] = ep_[3]; }
DI int dpp_x1(int v) { return __builtin_amdgcn_update_dpp(0, v, 0xB1, 0xF, 0xF, true); }
DI int dpp_x2(int v) { return __builtin_amdgcn_update_dpp(0, v, 0x4E, 0xF, 0xF, true); }
DI int dpp_x8(int v) { return __builtin_amdgcn_update_dpp(0, v, 0x128, 0xF, 0xF, true); }
DI int shxi(int v, int mask, int lane) { return __builtin_amdgcn_ds_bpermute((lane ^ mask) << 2, v); }

DI void p8a_compute(const u32x4 (&ur)[16], const u32x4& xq, bf16_t* dst, int lane, int eg) {
    int part[16];
#pragma unroll
    for (int b = 0; b < 16; ++b) {
        int acc = 0;
#pragma unroll
        for (int d = 0; d < 4; ++d) acc = __builtin_amdgcn_sdot4((int)ur[b][d], (int)xq[d], acc, false);
        part[b] = acc;
    }
    int v8[8], v4[4], v2[2];
    { const bool up = lane & 1;
#pragma unroll
      for (int q = 0; q < 8; ++q) { const int send = up ? part[q] : part[8 + q]; const int recv = dpp_x1(send); v8[q] = (up ? part[8 + q] : part[q]) + recv; } }
    { const bool up = lane & 2;
#pragma unroll
      for (int q = 0; q < 4; ++q) { const int send = up ? v8[q] : v8[4 + q]; const int recv = dpp_x2(send); v4[q] = (up ? v8[4 + q] : v8[q]) + recv; } }
    { const bool up = lane & 4;
#pragma unroll
      for (int q = 0; q < 2; ++q) { const int send = up ? v4[q] : v4[2 + q]; const int recv = shxi(send, 4, lane); v2[q] = (up ? v4[2 + q] : v4[q]) + recv; } }
    const int b0 = 8 * (lane & 1) + 4 * ((lane >> 1) & 1) + 2 * ((lane >> 2) & 1);
    dst[8 * b0 + eg] = f2bf((float)v2[0]);
    dst[8 * (b0 + 1) + eg] = f2bf((float)v2[1]);
}

DI void p8a_phase(const Params& p, int layer, unsigned* ctr8, volatile int* slot, bool rep = false) {
    const int emask = (PROBE_HOT && rep) ? 63 : 0x7fffffff;
    const int lane = ltid() & 63, w = ltid() >> 6, sub = lane & 7, eg = lane >> 3;
    int slice = (int)(xb_xcc_id() & 7u);
    const unsigned char* PU = (const unsigned char*)(p.ws + OFF_PU) + (size_t)layer * NEXP * D;
    bf16_t* PD = (bf16_t*)(p.ws + OFF_PD);
    const int* EI = (const int*)(p.ws + OFF_EIDX);
    for (;;) {
        const int g = p8_next(ctr8, slot, slice, layer);
        if (g < 0) break;
        const unsigned char* Us = PU + (size_t)slice * SLICE_BYTES;
        const unsigned lo16_ = 16u * sub;
        const int nb = (g * 4 + w) * P8_TPW;
        const unsigned char* xbase = (const unsigned char*)(p.ws + OFF_XQ) + slice * 128 + 16 * sub;
        bf16_t* pdb = PD + (size_t)slice * NTOK * 128;
        i32x4b eA[4], eB[4];
        P8_LOADE(eA, nb); P8_LOADE(eB, nb + 1);
        u32x4 urA[16], urB[16], xA, xB;
        P8_ISSUE_M(urA, eA, Us, emask);
        xA = *(const u32x4*)(xbase + (size_t)nb * D);
        for (int tt = 0; tt < P8_TPW; tt += 2) {
            const int n = nb + tt;
            { const int n2 = tt + 2 < P8_TPW ? n + 2 : n; P8_LOADE(eA, n2); }
            P8_ISSUE_M(urB, eB, Us, emask);
            xB = *(const u32x4*)(xbase + (size_t)(n + 1) * D);
            __builtin_amdgcn_sched_barrier(0);
            p8a_compute(urA, xA, pdb + (size_t)n * 128, lane, eg);
            __builtin_amdgcn_sched_barrier(0);
            if (tt + 2 < P8_TPW) {
                { const int n3 = tt + 3 < P8_TPW ? n + 3 : n; P8_LOADE(eB, n3); }
                P8_ISSUE_M(urA, eA, Us, emask);
                xA = *(const u32x4*)(xbase + (size_t)(n + 2) * D);
            }
            __builtin_amdgcn_sched_barrier(0);
            p8a_compute(urB, xB, pdb + (size_t)(n + 1) * 128, lane, eg);
            __builtin_amdgcn_sched_barrier(0);
        }
    }
}

DI void p8b_compute(const Params& p, int layer, const u32x4 (&vr)[16], const u32x4& wq, float sw, int n, int slice, int lane, int sub, int eg, bool rep = false) {
    int f[16];
#pragma unroll
    for (int e = 0; e < 16; ++e) f[e] = 0;
#pragma unroll
    for (int j = 0; j < 4; ++j)
#pragma unroll
        for (int d = 0; d < 4; ++d) {
            const unsigned r0 = vr[4 * j][d], r1 = vr[4 * j + 1][d], r2 = vr[4 * j + 2][d], r3 = vr[4 * j + 3][d];
            const unsigned t01l = __builtin_amdgcn_perm(r1, r0, 0x05010400u), t01h = __builtin_amdgcn_perm(r1, r0, 0x07030602u);
            const unsigned t23l = __builtin_amdgcn_perm(r3, r2, 0x05010400u), t23h = __builtin_amdgcn_perm(r3, r2, 0x07030602u);
            const unsigned c0 = __builtin_amdgcn_perm(t23l, t01l, 0x05040100u), c1 = __builtin_amdgcn_perm(t23l, t01l, 0x07060302u);
            const unsigned c2 = __builtin_amdgcn_perm(t23h, t01h, 0x05040100u), c3 = __builtin_amdgcn_perm(t23h, t01h, 0x07060302u);
            f[4 * d + 0] = __builtin_amdgcn_sdot4((int)c0, (int)wq[j], f[4 * d + 0], false);
            f[4 * d + 1] = __builtin_amdgcn_sdot4((int)c1, (int)wq[j], f[4 * d + 1], false);
            f[4 * d + 2] = __builtin_amdgcn_sdot4((int)c2, (int)wq[j], f[4 * d + 2], false);
            f[4 * d + 3] = __builtin_amdgcn_sdot4((int)c3, (int)wq[j], f[4 * d + 3], false);
        }
    int r8[8], r4[4], r2[2];
    { const bool up = lane & 8;
#pragma unroll
      for (int q = 0; q < 8; ++q) { const int send = up ? f[q] : f[8 + q]; const int recv = dpp_x8(send); r8[q] = (up ? f[8 + q] : f[q]) + recv; } }
    { const bool up = lane & 16;
#pragma unroll
      for (int q = 0; q < 4; ++q) { const int send = up ? r8[q] : r8[4 + q]; const int recv = shxi(send, 16, lane); r4[q] = (up ? r8[4 + q] : r8[q]) + recv; } }
    { const bool up = lane & 32;
#pragma unroll
      for (int q = 0; q < 2; ++q) { const int send = up ? r4[q] : r4[2 + q]; const int recv = shxi(send, 32, lane); r2[q] = (up ? r4[2 + q] : r4[q]) + recv; } }
    const int j2 = 4 * ((lane >> 3) & 1) + 2 * ((lane >> 4) & 1) + ((lane >> 5) & 1);
    const int col = slice * 128 + 16 * sub + 2 * j2;
    float* xr = xcur_row(p, n) + col;
    const f32x2 xv = *(const f32x2*)xr, gv = *(const f32x2*)(mod_vec(p, layer, n) + 5120 + col);
    f32x2 o; o[0] = fmaf(gv[0] * sw, (float)r2[0], xv[0]); o[1] = fmaf(gv[1] * sw, (float)r2[1], xv[1]);
    if (rep) *(f32x2*)((float*)(p.ws + OFF_PROJ) + (size_t)n * D + col) = o; else *(f32x2*)xr = o;
}

DI void p8b_phase(const Params& p, int layer, unsigned* ctr8, volatile int* slot, bool rep = false) {
    const int lane = ltid() & 63, w = ltid() >> 6, sub = lane & 7, eg = lane >> 3;
    int slice = (int)(xb_xcc_id() & 7u);
    const unsigned char* PV = (const unsigned char*)(p.ws + OFF_PV) + (size_t)layer * NEXP * D;
    const int* EI = (const int*)(p.ws + OFF_EIDX);
    const unsigned char* WQ = (const unsigned char*)(p.ws + OFF_WQ8) + 16 * eg;
    const float* SW = (const float*)(p.ws + OFF_SW);
    for (;;) {
        const int g = p8_next(ctr8, slot, slice, layer);
        if (g < 0) break;
        const unsigned char* Vs = PV + (size_t)slice * SLICE_BYTES;
        const unsigned lo16_ = 16u * sub;
        const int nb = (g * 4 + w) * P8_TPW;
        i32x4b eA[4], eB[4];
        P8_LOADE(eA, nb); P8_LOADE(eB, nb + 1);
        u32x4 vrA[16], vrB[16], wA, wB; float sA, sB;
        P8_ISSUE(vrA, eA, Vs);
        wA = *(const u32x4*)(WQ + (size_t)nb * 128); sA = SW[nb];
        for (int tt = 0; tt < P8_TPW; tt += 2) {
            const int n = nb + tt;
            { const int n2 = tt + 2 < P8_TPW ? n + 2 : n; P8_LOADE(eA, n2); }
            P8_ISSUE(vrB, eB, Vs);
            wB = *(const u32x4*)(WQ + (size_t)(n + 1) * 128); sB = SW[n + 1];
            __builtin_amdgcn_sched_barrier(0);
            p8b_compute(p, layer, vrA, wA, sA, n, slice, lane, sub, eg, rep);
            __builtin_amdgcn_sched_barrier(0);
            if (tt + 2 < P8_TPW) {
                { const int n3 = tt + 3 < P8_TPW ? n + 3 : n; P8_LOADE(eB, n3); }
                P8_ISSUE(vrA, eA, Vs);
                wA = *(const u32x4*)(WQ + (size_t)(n + 2) * 128); sA = SW[n + 2];
            }
            __builtin_amdgcn_sched_barrier(0);
            p8b_compute(p, layer, vrB, wB, sB, n + 1, slice, lane, sub, eg, rep);
            __builtin_amdgcn_sched_barrier(0);
        }
    }
}
#undef P8_ISSUE
#undef P8_ISSUE_M
#undef P8_LOADE

DI void p8w_phase(const Params& p) {
    const int lane = ltid() & 63;
    const int gw = blockIdx.x * 4 + (ltid() >> 6), nw = gridDim.x * 4;
    const bf16_t* PD = (const bf16_t*)(p.ws + OFF_PD);
    const float* G = (const float*)(p.ws + OFF_GATE);
    const float* S = (const float*)(p.ws + OFF_SUE);
    const float* SX = (const float*)(p.ws + OFF_SXQ);
    for (int n = gw; n < NTOK; n += nw) {
        float d_lo = 0.f, d_hi = 0.f;
#pragma unroll
        for (int s = 0; s < 8; ++s) { const bf16_t* pd = PD + ((size_t)s * NTOK + n) * 128; d_lo += bf2f(pd[lane]); d_hi += bf2f(pd[64 + lane]); }
        const float sx = SX[n];
        const size_t i = (size_t)n * 128 + lane;
        const float w_lo = gelu_exact(d_lo * (S[i] * sx)) * G[i], w_hi = gelu_exact(d_hi * (S[i + 64] * sx)) * G[i + 64];
        float am = fmaxf(fabsf(w_lo), fabsf(w_hi));
#pragma unroll
        for (int o = 32; o > 0; o >>= 1) am = fmaxf(am, shx(am, o, lane));
        const float sc = am > 0.f ? am * (1.f / 127.f) : 1.f, inv = 1.f / sc;
        unsigned char* wq = (unsigned char*)(p.ws + OFF_WQ8) + (size_t)n * 128;
        wq[(lane & 7) * 16 + (lane >> 3)] = (unsigned char)(__float2int_rn(w_lo * inv) & 255);
        wq[(lane & 7) * 16 + 8 + (lane >> 3)] = (unsigned char)(__float2int_rn(w_hi * inv) & 255);
        if (lane == 0) ((float*)(p.ws + OFF_SW))[n] = sc;
    }
}

DI void final_norm_phase(const Params& p) {
    const int lane = ltid() & 63;
    const int gw = blockIdx.x * 4 + (ltid() >> 6), nw = gridDim.x * 4;
    for (int i = gw; i < NB * T; i += nw) {
        float* row = p.out + (size_t)i * D;
        f32x4 v[4]; load_row16(row, lane, v);
        const float rstd = row_rstd(v, lane);
#pragma unroll
        for (int q = 0; q < 4; ++q) {
            const int c = 4 * lane + 256 * q;
            const f32x4 gv = *(const f32x4*)(p.in[22] + c);
            f32x4 o;
#pragma unroll
            for (int e = 0; e < 4; ++e) o[e] = v[q][e] * rstd * gv[e];
            *(f32x4*)(row + c) = o;
        }
    }
}
constexpr int P3_MLA = NB * 4 * (T / 256);
constexpr int P3_NA = NB * 4 * (T / 128);
constexpr int P3_SWA = NB * 4 * (T / 128);
constexpr int P3_CTX = 3 * NB * 4 * 2;
constexpr int P3_TAB = TAB_ITEMS;
constexpr int P3_ATT = P3_SCAN + P3_MLA + P3_NA + P3_SWA + P3_CTX;
constexpr int P3_ITEMS = P3_ATT + P4_ITEMS;

DI void p3_item(const Params& p, int layer, int item, char* lds, bool rep = false) {
    unsigned* scan_done = (unsigned*)(p.ws + OFF_CTL) + 128 + layer;
    if (item < P3_SCAN) {
        p3_scan(p, item);
        asm volatile("s_waitcnt vmcnt(0)" ::: "memory");
        __syncthreads();
        if (threadIdx.x == 0) { __builtin_amdgcn_fence(__ATOMIC_RELEASE, "agent"); asm volatile("s_waitcnt vmcnt(0)" ::: "memory"); __hip_atomic_fetch_add(scan_done, 1u, __ATOMIC_RELAXED, __HIP_MEMORY_SCOPE_AGENT); }
        return;
    }
    if (item >= P3_ATT) {
        if (threadIdx.x == 0) {
            unsigned spins = 0;
            while (__hip_atomic_load(scan_done, __ATOMIC_RELAXED, __HIP_MEMORY_SCOPE_AGENT) < (unsigned)P3_SCAN && ++spins < (1u << 22)) __builtin_amdgcn_s_sleep(2);
            __builtin_amdgcn_fence(__ATOMIC_ACQUIRE, "agent");
            asm volatile("s_waitcnt vmcnt(0)" ::: "memory");
        }
        __syncthreads();
        p4_mlstm_out(p, layer, item - P3_ATT, lds);
        return;
    }
    item -= P3_SCAN;
    const bf16_t* proj = (const bf16_t*)(p.ws + OFF_PROJ);
    bf16_t* Y = (bf16_t*)(p.ws + OFF_ACT);
    AttnJob J;
    J.has_sink = 0; J.sink2 = 0.f; J.tq0 = 0; J.probe = 0;
    if (item < P3_MLA) {
        const int b = item >> 8, hh = (item >> 6) & 3, qb = item & 63;
        const int n0 = b * P + CTXL + qb * 256;
        MlaJob M;
        M.Q = (const unsigned char*)(p.ws + OFF_QM) + ((size_t)n0 * 4 + hh) * 128;
        M.K = (const unsigned char*)(p.ws + OFF_KM) + (size_t)(b * 4 + hh) * P * 128;
        M.V = (const unsigned char*)(p.ws + OFF_VTM) + (size_t)(b * 4 + hh) * 64 * P;
        M.O = Y + (size_t)n0 * D + 512 + hh * 64; M.ldo = D;
        M.nkeys = P;
        attn_mla_mx(M, lds);
        return;
    }
    item -= P3_MLA;
    if (item < P3_NA) {
        const int b = item >> 9, hh = (item >> 7) & 3, rp = item & 127;
        const int n0 = b * P + CTXL + rp * 128;
        J.Q = proj + (size_t)n0 * PJ + C_NAQ + hh * 64; J.ldq = PJ;
        J.K = proj + (size_t)(b * P) * PJ + C_NAK + hh * 64; J.ldk = PJ;
        J.V = proj + (size_t)(b * P) * PJ + C_NAV + hh * 64; J.ldv = PJ;
        J.O = Y + (size_t)n0 * D + hh * 64; J.ldo = D;
        int ra = 2 * rp - 4; ra = ra < 0 ? 0 : (ra > 248 ? 248 : ra);
        int rb = 2 * rp + 1 - 4; rb = rb < 0 ? 0 : (rb > 248 ? 248 : rb);
        J.r0b = 0; J.r0e = CTXL; J.r1b = CTXL + ra * 64; J.r1e = CTXL + (rb + 8) * 64;
        J.tq0 = rp * 128;
        J.scale2 = 0.125f * LOG2E;
        float* rpb = (float*)(lds + ATT_RPB);
        __syncthreads();
        for (int i = ltid(); i < 15 * 31; i += 256) rpb[i] = p.in[9][((size_t)layer * 4 + hh) * 465 + i] * LOG2E;
        attn_job<64, false, 1>(J, lds);
        return;
    }
    item -= P3_NA;
    if (item < P3_SWA) {
        const int b = item >> 9, qh = (item >> 7) & 3, blk = item & 127;
        const int n0 = b * P + CTXL + blk * 128;
        J.Q = proj + (size_t)n0 * PJ + C_SWQ + qh * 64; J.ldq = PJ;
        J.K = proj + (size_t)(b * P) * PJ + C_SWK + (qh >> 1) * 64; J.ldk = PJ;
        J.V = proj + (size_t)(b * P) * PJ + C_SWV + (qh >> 1) * 64; J.ldv = PJ;
        J.O = Y + (size_t)n0 * D + 768 + qh * 64; J.ldo = D;
        int lo = blk * 128 - 128; lo = lo < 0 ? 0 : lo;
        int hi = blk * 128 + 256; hi = hi > T ? T : hi;
        J.r0b = 0; J.r0e = CTXL; J.r1b = CTXL + lo; J.r1e = CTXL + hi;
        J.tq0 = blk * 128;
        J.scale2 = 0.125f * LOG2E;
        J.has_sink = 1; J.sink2 = p.in[16][layer * 4 + qh] * LOG2E;
        attn_job<64, false, 2>(J, lds);
        return;
    }
    item -= P3_SWA;
    {
        const int kind = item / 16, b = (item >> 3) & 1, hh = (item >> 1) & 3, half = item & 1;
        const int n0 = b * P + half * 128;
        J.r0b = 0; J.r0e = CTXL; J.r1b = 0; J.r1e = 0;
        if (kind == 1) {
            if (half) return;
            MlaJob M;
            M.Q = (const unsigned char*)(p.ws + OFF_QM) + ((size_t)n0 * 4 + hh) * 128;
            M.K = (const unsigned char*)(p.ws + OFF_KM) + (size_t)(b * 4 + hh) * P * 128;
            M.V = (const unsigned char*)(p.ws + OFF_VTM) + (size_t)(b * 4 + hh) * 64 * P;
            M.O = Y + (size_t)n0 * D + 512 + hh * 64; M.ldo = D;
            M.nkeys = CTXL;
            attn_mla_mx(M, lds);
        } else {
            const int cq = kind == 0 ? C_NAQ + hh * 64 : C_SWQ + hh * 64;
            const int ck = kind == 0 ? C_NAK + hh * 64 : C_SWK + (hh >> 1) * 64;
            const int cv = kind == 0 ? C_NAV + hh * 64 : C_SWV + (hh >> 1) * 64;
            J.Q = proj + (size_t)n0 * PJ + cq; J.ldq = PJ;
            J.K = proj + (size_t)(b * P) * PJ + ck; J.ldk = PJ;
            J.V = proj + (size_t)(b * P) * PJ + cv; J.ldv = PJ;
            J.O = Y + (size_t)n0 * D + (kind == 0 ? 0 : 768) + hh * 64; J.ldo = D;
            J.scale2 = 0.125f * LOG2E;
            if (kind == 2) { J.has_sink = 1; J.sink2 = p.in[16][layer * 4 + hh] * LOG2E; }
            attn_job<64, false, 0>(J, lds);
        }
    }
}

DI void p2_item(const Params& p, int layer, int item, char* lds) {
    if (item < P2_MQ) { p2_mla_q(p, layer, item, lds); return; }
    item -= P2_MQ;
    if (item < P2_MKV) { p2_mla_kv(p, layer, item, lds); return; }
    item -= P2_MKV;
    if (item < P2_ML) { p2_mlstm(p, layer, item, lds); return; }
    item -= P2_ML;
    p2_rope(p, item);
}

#define QUEUE_LOOP(ctrp_, nitems_, body_)                                                                                  \
    { int it_cur_ = next_item((ctrp_), q_slot);                                                                            \
      while (it_cur_ < (nitems_)) {                                                                                        \
          int it_pre_ = 0;                                                                                                 \
          if (threadIdx.x == 0) it_pre_ = (int)atomicAdd((ctrp_), 1u);                                                     \
          { const int it = it_cur_; body_; }                                                                               \
          __syncthreads();                                                                                                 \
          if (threadIdx.x == 0) *q_slot = it_pre_;                                                                         \
          __syncthreads();                                                                                                 \
          it_cur_ = *q_slot; } }
DI int xq_next(unsigned* ctr8, volatile int* slot, int& q, int nmt, int per_mt) {
    __syncthreads();
    if (threadIdx.x == 0) {
        int qq = q, g = -1;
        for (int tries = 0; tries < 8; ++tries) {
            const int lo = qq * nmt / 8, hi = (qq + 1) * nmt / 8;
            const int v = (int)atomicAdd(&ctr8[qq], 1u);
            if (v < (hi - lo) * per_mt) { g = (lo + v / per_mt) * per_mt + v % per_mt; break; }
            qq = (qq + 1) & 7;
        }
        slot[0] = g; slot[1] = qq;
    }
    __syncthreads();
    q = slot[1];
    return slot[0];
}

#ifndef REP_PHASE
#define REP_PHASE -1
#endif
DI void run_phase(const Params& p, int ph, bool rep, char* lds, volatile int* q_slot) {
    unsigned* ctr = (unsigned*)(p.ws + OFF_CTL) + (rep ? 32 : 0);
    if (ph == 0) {
        for (int it = blockIdx.x; it < P0_TOTAL; it += gridDim.x) phase0_item(p, it, lds);
    } else if (ph == 1) {
        phase_norm(p, 0, 0, true);
        for (int it = blockIdx.x; it < 2 * Q8_LAYER; it += gridDim.x) q8_item(p, it, lds);
    } else {
        const int layer = (ph - 2) / 10; int sub = (ph - 2) % 10; if (sub >= 3) ++sub;
        if (sub == 0) {
            for (;;) { const int it = next_item(&ctr[ph], q_slot); if (it >= P1_ITEMS) break; p1_item(p, layer, it, lds, rep); }
        } else if (sub == 1) {
            for (;;) { const int it = next_item(&ctr[ph], q_slot); if (it >= P2_ITEMS) break; if (rep && it >= P2_ITEMS - P2_ROPE) continue;
                if (rep && PROBE_VARIANT == 10 && it >= P2_MQ) continue; if (rep && PROBE_VARIANT == 11 && (it < P2_MQ || it >= P2_MQ + P2_MKV)) continue; if (rep && PROBE_VARIANT == 12 && it < P2_MQ + P2_MKV) continue;
                p2_item(p, layer, it, lds); }
        } else if (sub == 2) {
            for (;;) { const int it = next_item(&ctr[ph], q_slot); if (it >= P3_ITEMS) break; if (rep && (it < P3_SCAN || it >= P3_SCAN + P3_MLA)) continue; p3_item(p, layer, it, lds, rep); }
        } else if (sub == 3) {
            for (;;) { const int it = next_item(&ctr[ph], q_slot); if (it >= P4_ITEMS) break; p4_mlstm_out(p, layer, it, lds); }
        } else if (sub == 4) {
            { const int nit = layer == 0 ? P5_ITEMS : 2048;
              for (;;) { int it = next_item(&ctr[ph], q_slot); if (it >= nit) break; if (layer) { const int lt = it >> 3; it = ((lt >> 7) * 130 + 2 + (lt & 127)) * 8 + (it & 7); } p5_item(p, layer, it, lds); } }
        } else if (sub == 5) {
            phase_norm(p, layer, 1, false);
        } else if (sub == 6) {
            { const int nit = layer == 0 ? P7_ITEMS : 2048;
              for (;;) { int it = next_item(&ctr[ph], q_slot); if (it >= nit) break; if (layer) { const int lt = it >> 3; it = ((lt >> 7) * 130 + 2 + (lt & 127)) * 8 + (it & 7); } p7_item(p, layer, it, lds); } }
        } else if (sub == 7) {
            p8a_phase(p, layer, (unsigned*)(p.ws + OFF_CTL) + 64 + (rep ? 32 : 0) + (layer * 2 + 0) * 8, q_slot, rep);
        } else if (sub == 8) {
            p8w_phase(p);
        } else if (sub == 9) {
            p8b_phase(p, layer, (unsigned*)(p.ws + OFF_CTL) + 64 + (rep ? 32 : 0) + (layer * 2 + 1) * 8, q_slot, rep);
        } else {
            if (layer == 0) phase_norm(p, 1, 0, false); else final_norm_phase(p);
        }
    }
}

#define XB_TMO      128
#define XB_XCNT(j)  (256  + 64 * (j))
#define XB_XSUB(j)  (1280 + 64 * (j))
#define XB_XGEN(j)  (2304 + 64 * (j))
#define XB_TOP      3328
#define XB_TOPGEN   3392
#define XCD_BAR_WORDS 3456
#define XB_SPIN_CAP (1u << 18)
#define LAS __attribute__((address_space(3)))
DI unsigned xb_ld(unsigned* p) { return __hip_atomic_load(p, __ATOMIC_RELAXED, __HIP_MEMORY_SCOPE_AGENT); }
DI unsigned xb_add(unsigned* p, unsigned v) { return __hip_atomic_fetch_add(p, v, __ATOMIC_RELAXED, __HIP_MEMORY_SCOPE_AGENT); }
#define XB_SPIN(cond, bar) do { unsigned _sp = 0; while (cond) { __builtin_amdgcn_s_sleep(1); \
    if ((++_sp & 255u) == 0u) { if (xb_ld(&(bar)[XB_TMO])) break; if (_sp > XB_SPIN_CAP) { atomicAdd(&(bar)[XB_TMO], 1u); break; } } } } while (0)
struct XcdBarrier { unsigned* bar; unsigned x; volatile LAS unsigned* st; };
DI XcdBarrier xcd_barrier_post(unsigned* bar, volatile LAS unsigned* st) {
    XcdBarrier b; b.bar = bar; b.x = xb_xcc_id(); b.st = st;
    if (threadIdx.x == 0) (void)xb_add(&bar[XB_XCNT(b.x)], 1u);
    return b;
}
DI void xcd_barrier_complete(unsigned* bar, unsigned x, unsigned& nloc, unsigned& nx) {
    const unsigned G = gridDim.x * gridDim.y * gridDim.z;
    unsigned sum, cnt, mine, sp = 0u;
    for (;;) {
        sum = 0u; cnt = 0u; mine = 0u;
#pragma unroll
        for (unsigned j = 0; j < 16; ++j) { const unsigned c = xb_ld(&bar[XB_XCNT(j)]); sum += c; cnt += (c > 0u) ? 1u : 0u; mine = (j == x) ? c : mine; }
        if (sum == G) break;
        __builtin_amdgcn_s_sleep(1);
        if ((++sp & 255u) == 0u) { if (xb_ld(&bar[XB_TMO])) break; if (sp > XB_SPIN_CAP) { atomicAdd(&bar[XB_TMO], 1u); break; } }
    }
    nloc = mine > 0u ? mine : 1u; nx = cnt > 0u ? cnt : 1u;
}
DI void xcd_barrier(const XcdBarrier& b) {
    asm volatile("s_waitcnt vmcnt(0)" ::: "memory");
    __syncthreads();
    if (threadIdx.x == 0) {
        unsigned* bar = b.bar;
        __builtin_amdgcn_s_waitcnt(0);
        unsigned nloc = b.st[0], nx = b.st[1];
        if (nloc == 0u) { xcd_barrier_complete(bar, b.x, nloc, nx); b.st[0] = nloc; b.st[1] = nx; }
        const unsigned old = xb_add(&bar[XB_XSUB(b.x)], 1u);
        const unsigned gen = old / nloc;
        if (old + 1u == (gen + 1u) * nloc) {
            __builtin_amdgcn_fence(__ATOMIC_RELEASE, "agent");
            asm volatile("s_waitcnt vmcnt(0)" ::: "memory");
            const unsigned og = xb_add(&bar[XB_TOP], 1u);
            const unsigned tg = og / nx;
            if (og + 1u == (tg + 1u) * nx) xb_add(&bar[XB_TOPGEN], 1u);
            else XB_SPIN(xb_ld(&bar[XB_TOPGEN]) == tg, bar);
            __builtin_amdgcn_fence(__ATOMIC_ACQUIRE, "agent");
            xb_add(&bar[XB_XGEN(b.x)], 1u);
            asm volatile("s_waitcnt vmcnt(0)" ::: "memory");
        } else {
            XB_SPIN(xb_ld(&bar[XB_XGEN(b.x)]) == gen, bar);
            __builtin_amdgcn_fence(__ATOMIC_ACQUIRE, "agent");
            asm volatile("s_waitcnt vmcnt(0)" ::: "memory");
        }
    }
    __syncthreads();
}

typedef const __attribute__((address_space(4))) char* kaptr_t;
__global__ void __launch_bounds__(256, 2) fwd_megakernel(Params p_unused) {
    extern __shared__ __attribute__((aligned(16))) char lds[];
    __shared__ __attribute__((aligned(16))) unsigned sm4[4];
    cg::grid_group grid = cg::this_grid();
    kaptr_t ka = (kaptr_t)__builtin_amdgcn_kernarg_segment_ptr();
    const int ph_lo = ((const Params*)ka)->ph_lo, ph_hi = ((const Params*)ka)->ph_hi;
    volatile int* q_slot = (volatile int*)&sm4[0];
    if (threadIdx.x < 4) sm4[threadIdx.x] = 0u;
    __syncthreads();
    const XcdBarrier xb = xcd_barrier_post((unsigned*)(((const Params*)ka)->ws + OFF_BAR), (volatile LAS unsigned*)&sm4[2]);
    for (int ph = ph_lo; ph < ph_hi; ++ph) {
        asm volatile("" : "+s"(ka));
        const Params& p = *(const Params*)ka;
        if (REP_PHASE >= 0 && ph == REP_PHASE) { run_phase(p, ph, true, lds, q_slot); xcd_barrier(xb); }
        run_phase(p, ph, false, lds, q_slot);
        if (ph + 1 < ph_hi) { if (ph_hi > 1000) grid.sync(); else xcd_barrier(xb); }
    }
}

extern "C" void kernel_launch(void* const* d_in, const int* in_sizes, int n_in, void* d_out, int out_size, void* d_ws, size_t ws_size, hipStream_t stream) {
    static int grid_blocks = 0;
    if (grid_blocks == 0) {
        if (n_in != 23 || ws_size < WS_END) { fprintf(stderr, "kernel_launch: unexpected n_in %d or ws_size %zu (need %zu)\n", n_in, ws_size, (size_t)WS_END); grid_blocks = -1; return; }
        int dev = 0, cus = 0, per_cu = 0;
        hipGetDevice(&dev);
        hipDeviceGetAttribute(&cus, hipDeviceAttributeMultiprocessorCount, dev);
        hipFuncSetAttribute((const void*)fwd_megakernel, hipFuncAttributeMaxDynamicSharedMemorySize, LDS_BYTES);
        hipOccupancyMaxActiveBlocksPerMultiprocessor(&per_cu, (const void*)fwd_megakernel, 256, LDS_BYTES);
        if (per_cu < 1) { fprintf(stderr, "kernel_launch: occupancy query returned %d\n", per_cu); grid_blocks = -1; return; }
        if (per_cu > 2) per_cu = 2;
        grid_blocks = cus * per_cu;
        fprintf(stderr, "kernel_launch: grid %d (%d CUs x %d)\n", grid_blocks, cus, per_cu);
    }
    if (grid_blocks < 0) return;
    hipMemsetAsync((char*)d_ws + OFF_CTL, 0, CTL_BYTES, stream);
    Params p{};
    for (int i = 0; i < 23; ++i) p.in[i] = (const float*)d_in[i];
    p.out = (float*)d_out; p.ws = (char*)d_ws; p.ph_lo = 0; p.ph_hi = NPHASE;
    void* args[] = {&p};
    hipError_t e = hipLaunchCooperativeKernel((const void*)fwd_megakernel, dim3(grid_blocks), dim3(256), args, LDS_BYTES, stream);
    if (e != hipSuccess) fprintf(stderr, "kernel_launch: cooperative launch failed: %s (grid %d)\n", hipGetErrorString(e), grid_blocks);
}
```

```cpp
#include <hip/hip_runtime.h>
#include <hip/hip_cooperative_groups.h>
#include <cstdio>
#include <cstdint>
namespace cg = cooperative_groups;

typedef unsigned short bf16_t;
typedef short bf16x8 __attribute__((ext_vector_type(8)));
typedef short s16x4 __attribute__((ext_vector_type(4)));
typedef float f32x16 __attribute__((ext_vector_type(16)));
typedef float f32x4 __attribute__((ext_vector_type(4)));
typedef float f32x2 __attribute__((ext_vector_type(2)));
typedef unsigned u32x4 __attribute__((ext_vector_type(4)));
typedef unsigned u32x2 __attribute__((ext_vector_type(2)));
typedef __bf16 bf2_t __attribute__((ext_vector_type(2)));

#define DI __device__ __forceinline__
#define MFMA32(a, b, c) __builtin_amdgcn_mfma_f32_32x32x16_bf16((a), (b), (c), 0, 0, 0)

constexpr int D = 1024, NB = 2, T = 16384, CTXL = 256;
constexpr int P = T + CTXL;
constexpr int NTOK = NB * P;
constexpr int NCH = P / 64;
constexpr int PJ = 2736;
constexpr int PJP = 2816;
constexpr int C_NAQ = 0, C_NAK = 256, C_NAV = 512, C_MLQ = 768, C_MLK = 1024, C_MLV = 1280, C_MLO = 1536, C_MLG = 1792,
              C_CQ = 1808, C_CKV = 2064, C_KR = 2192, C_SWQ = 2224, C_SWK = 2480, C_SWV = 2608;
constexpr float EPS = 1e-6f;
constexpr float LOG2E = 1.4426950408889634f;
constexpr int NEXP = 16384;

constexpr size_t al256(size_t x) { return (x + 255) & ~(size_t)255; }
constexpr size_t OFF_CTL = 0;
constexpr size_t OFF_BAR = 1024;
constexpr size_t CTL_BYTES = 16384;
constexpr size_t OFF_MOD = CTL_BYTES;
constexpr size_t OFF_XC = al256(OFF_MOD + 2 * 3 * 6144 * 4);
constexpr size_t OFF_WIN = al256(OFF_XC + (size_t)NB * CTXL * D * 4);
constexpr size_t OFF_WOUT = al256(OFF_WIN + (size_t)2 * PJP * D * 2);
constexpr size_t OFF_WQ = al256(OFF_WOUT + (size_t)2 * D * D * 2);
constexpr size_t OFF_KEYS = al256(OFF_WQ + (size_t)2 * 2048 * D * 2);
constexpr size_t OFF_WUQ = al256(OFF_KEYS + (size_t)2 * 16 * 128 * 128 * 2);
constexpr size_t OFF_WUKV = al256(OFF_WUQ + (size_t)2 * 384 * 256 * 2);
constexpr size_t OFF_PU = al256(OFF_WUKV + (size_t)2 * 512 * 128 * 2);
constexpr size_t OFF_PV = al256(OFF_PU + (size_t)NEXP * D * 2);
constexpr size_t OFF_ACT = al256(OFF_PV + (size_t)NEXP * D * 2);
constexpr size_t OFF_PROJ = al256(OFF_ACT + (size_t)NTOK * D * 2);
constexpr size_t OFF_GATES = al256(OFF_PROJ + (size_t)NTOK * PJ * 2);
constexpr size_t OFF_QM = al256(OFF_GATES + (size_t)NTOK * 16 * 4);
constexpr size_t OFF_KM = al256(OFF_QM + (size_t)NTOK * 384 * 2);
constexpr size_t OFF_VTM = al256(OFF_KM + (size_t)NTOK * 384 * 2);
constexpr size_t OFF_QC = al256(OFF_VTM + (size_t)NB * 4 * 64 * P * 2);
constexpr size_t OFF_KC = al256(OFF_QC + (size_t)NTOK * 256 * 2);
constexpr size_t OFF_UB = al256(OFF_KC + (size_t)NTOK * 256 * 2);
constexpr size_t OFF_UN = al256(OFF_UB + (size_t)16 * NCH * 4096 * 2);
constexpr size_t OFF_META = al256(OFF_UN + (size_t)16 * NCH * 64 * 4);
constexpr size_t OFF_GB = al256(OFF_META + (size_t)16 * NCH * 4 * 4);
constexpr size_t OFF_EIDX = al256(OFF_GB + (size_t)2 * NTOK * 4 * 2 * 4);
constexpr size_t OFF_GATE = al256(OFF_EIDX + (size_t)NTOK * 128 * 4);
constexpr size_t OFF_PSC = al256(OFF_GATE + (size_t)NTOK * 128 * 4);
constexpr size_t WS_END = al256(OFF_PSC + (size_t)2 * 2 * NEXP * 4);

constexpr int LDS_BYTES = 76 * 1024;
constexpr size_t OFF_SUE = OFF_QM;
constexpr size_t OFF_WQ8 = OFF_QM + (size_t)NTOK * 128 * 4;
constexpr size_t OFF_SW = OFF_WQ8 + (size_t)NTOK * 128;
constexpr size_t OFF_XQ = OFF_QC;
constexpr size_t OFF_SXQ = OFF_UN;
constexpr size_t OFF_LSTG = OFF_PROJ;
constexpr size_t OFF_PD = OFF_PROJ + (size_t)40 * 1024 * 1024;
constexpr size_t OFF_HQ = OFF_ACT;
constexpr size_t OFF_SH = OFF_ACT + (size_t)NTOK * D;
constexpr size_t OFF_SWIN = OFF_WIN + (size_t)2 * PJP * D;
constexpr size_t OFF_SWQ = OFF_WQ + (size_t)2 * 2048 * D;
constexpr size_t OFF_DELTA = OFF_QM;
constexpr int NPHASE = 22;

struct Params {
    const float* in[23];
    float* out;
    char* ws;
    int ph_lo, ph_hi;
};

DI unsigned pk2(float a, float b) { f32x2 v = {a, b}; bf2_t r = __builtin_convertvector(v, bf2_t); return __builtin_bit_cast(unsigned, r); }
DI float bflo(unsigned u) { return __uint_as_float(u << 16); }
DI float bfhi(unsigned u) { return __uint_as_float(u & 0xffff0000u); }
DI float bf2f(bf16_t v) { return __uint_as_float(((unsigned)v) << 16); }
DI bf16_t f2bf(float f) { return (bf16_t)(pk2(f, 0.f) & 0xffffu); }
DI int crow(int reg, int h) { return (reg & 3) + 8 * (reg >> 2) + 4 * h; }
DI float fmax2(float a, float b) { return __builtin_amdgcn_fmed3f(a, b, __builtin_inff()); }
DI float fexp2(float x) { return __builtin_amdgcn_exp2f(x); }
DI float fexp(float x) { return __builtin_amdgcn_exp2f(x * LOG2E); }
DI float siluf(float x) { return x / (1.f + __expf(-x)); }
DI float sigmoidf_(float x) { return 1.f / (1.f + __expf(-x)); }
DI float logsigmoidf_(float x) { return fminf(x, 0.f) - log1pf(__expf(-fabsf(x))); }
DI float shx(float v, int mask, int lane) { return __builtin_bit_cast(float, __builtin_amdgcn_ds_bpermute((lane ^ mask) << 2, __builtin_bit_cast(int, v))); }
DI unsigned shxu(unsigned v, int mask, int lane) { return (unsigned)__builtin_amdgcn_ds_bpermute((lane ^ mask) << 2, (int)v); }
DI float shfrom(float v, int src) { return __builtin_bit_cast(float, __builtin_amdgcn_ds_bpermute(src << 2, __builtin_bit_cast(int, v))); }

DI void sincos_cw(float x, float& s, float& c) {
    const float k = rintf(x * 0.6366197723675814f);
    float r = fmaf(k, -1.5707962512969971f, x);
    r = fmaf(k, -7.5497894158615964e-08f, r);
    const float r2 = r * r;
    float sp = fmaf(r2, 2.7557319e-6f, -1.9841270e-4f); sp = fmaf(sp, r2, 8.3333333e-3f); sp = fmaf(sp, r2, -1.6666667e-1f); sp = fmaf(sp * r2, r, r);
    float cp = fmaf(r2, 2.4801587e-5f, -1.3888889e-3f); cp = fmaf(cp, r2, 4.1666667e-2f); cp = fmaf(cp, r2, -0.5f); cp = fmaf(cp, r2, 1.f);
    const int q = ((int)k) & 3;
    const float ss = (q & 1) ? cp : sp, cc = (q & 1) ? sp : cp;
    s = (q & 2) ? -ss : ss;
    c = ((q + 1) & 2) ? -cc : cc;
}

DI int tok_b(int n) { return n >= P ? 1 : 0; }
DI const float* xin_row(const Params& p, int layer, int n) {
    const int b = tok_b(n), pos = n - b * P;
    if (layer == 0) return pos < CTXL ? p.in[2] + (size_t)(b * CTXL + pos) * D : p.in[0] + (size_t)(b * T + pos - CTXL) * D;
    return pos < CTXL ? (const float*)(p.ws + OFF_XC) + (size_t)(b * CTXL + pos) * D : p.out + (size_t)(b * T + pos - CTXL) * D;
}
DI float* xcur_row(const Params& p, int n) {
    const int b = tok_b(n), pos = n - b * P;
    return pos < CTXL ? (float*)(p.ws + OFF_XC) + (size_t)(b * CTXL + pos) * D : p.out + (size_t)(b * T + pos - CTXL) * D;
}
DI const float* mod_vec(const Params& p, int layer, int n) {
    const int b = tok_b(n), pos = n - b * P;
    return (const float*)(p.ws + OFF_MOD) + (size_t)(layer * 3 + (pos < CTXL ? 2 : b)) * 6144;
}

#ifndef PROBE_VARIANT
#define PROBE_VARIANT 0
#endif
#ifndef PROBE_HOT
#define PROBE_HOT 0
#endif
DI unsigned xb_xcc_id() { return (unsigned)__builtin_amdgcn_s_getreg((3 << 11) | 20) & 0xFu; }
DI int ltid() { int t = threadIdx.x; asm volatile("" : "+v"(t)); return t; }
DI int next_item(unsigned* ctr, volatile int* slot) {
    __syncthreads();
    if (threadIdx.x == 0) *slot = (int)atomicAdd(ctr, 1u);
    __syncthreads();
    return __builtin_amdgcn_readfirstlane(*slot);
}
DI void transpose_tile(const float* __restrict__ src, int K, int N, bf16_t* __restrict__ dst, const float* __restrict__ gain, int kt, int nt, char* lds) {
    float* tl = (float*)lds;
    const int tid = ltid();
    __syncthreads();
#pragma unroll
    for (int i = 0; i < 4; ++i) {
        const int c = tid + 256 * i;
        const int kr = c >> 4, nc = (c & 15) * 4;
        const int k = kt * 64 + kr, n = nt * 64 + nc;
        f32x4 v = {0.f, 0.f, 0.f, 0.f};
        if (n < N) v = *(const f32x4*)(src + (size_t)k * N + n);
        if (gain) { const float g = gain[k]; v *= g; }
        tl[kr * 65 + nc + 0] = v[0]; tl[kr * 65 + nc + 1] = v[1]; tl[kr * 65 + nc + 2] = v[2]; tl[kr * 65 + nc + 3] = v[3];
    }
    __syncthreads();
#pragma unroll
    for (int i = 0; i < 2; ++i) {
        const int c = tid + 256 * i;
        const int nr = c >> 3, kc = (c & 7) * 8;
        u32x4 o;
        o[0] = pk2(tl[(kc + 0) * 65 + nr], tl[(kc + 1) * 65 + nr]);
        o[1] = pk2(tl[(kc + 2) * 65 + nr], tl[(kc + 3) * 65 + nr]);
        o[2] = pk2(tl[(kc + 4) * 65 + nr], tl[(kc + 5) * 65 + nr]);
        o[3] = pk2(tl[(kc + 6) * 65 + nr], tl[(kc + 7) * 65 + nr]);
        *(u32x4*)(dst + (size_t)(nt * 64 + nr) * K + kt * 64 + kc) = o;
    }
}

DI void convert_item(const float* __restrict__ src, bf16_t* __restrict__ dst, int item) {
    const size_t base = (size_t)item * 8192 + ltid() * 8;
#pragma unroll
    for (int i = 0; i < 4; ++i) {
        const size_t o = base + (size_t)i * 2048;
        const f32x4 a = *(const f32x4*)(src + o), b = *(const f32x4*)(src + o + 4);
        u32x4 r; r[0] = pk2(a[0], a[1]); r[1] = pk2(a[2], a[3]); r[2] = pk2(b[0], b[1]); r[3] = pk2(b[2], b[3]);
        *(u32x4*)(dst + o) = r;
    }
}

DI void adaln_item(const Params& p, int item, char* lds) {
    float* sv = (float*)lds;
    float* red = sv + 3 * 1024;
    const int tid = ltid();
    const int l = item / 96, cc = item % 96;
    __syncthreads();
    for (int i = tid; i < 3 * 1024; i += 256) {
        const int v = i >> 10, k = i & 1023;
        const float x = v < 2 ? p.in[1][v * 1024 + k] : p.in[3][k];
        sv[i] = siluf(x);
    }
    __syncthreads();
    const int col = cc * 64 + (tid & 63), ks = tid >> 6;
    const float* w = p.in[6] + (size_t)l * 1024 * 6144 + col;
    float a0 = 0.f, a1 = 0.f, a2 = 0.f;
#pragma unroll 8
    for (int k = ks * 256; k < ks * 256 + 256; ++k) {
        const float wv = w[(size_t)k * 6144];
        a0 = fmaf(wv, sv[k], a0); a1 = fmaf(wv, sv[1024 + k], a1); a2 = fmaf(wv, sv[2048 + k], a2);
    }
    red[(ks * 3 + 0) * 64 + (tid & 63)] = a0; red[(ks * 3 + 1) * 64 + (tid & 63)] = a1; red[(ks * 3 + 2) * 64 + (tid & 63)] = a2;
    __syncthreads();
    if (tid < 192) {
        const int v = tid >> 6, c = tid & 63;
        const float s = red[(0 * 3 + v) * 64 + c] + red[(1 * 3 + v) * 64 + c] + red[(2 * 3 + v) * 64 + c] + red[(3 * 3 + v) * 64 + c];
        const int gc = cc * 64 + c;
        ((float*)(p.ws + OFF_MOD))[(size_t)(l * 3 + v) * 6144 + gc] = s + p.in[7][l * 6144 + gc];
    }
}

constexpr int TR_WIN = 16 * 44, TR_WOUT = 16 * 16, TR_WQ = 16 * 32, TR_WUQ = 4 * 6, TR_WUKV = 2 * 8;
constexpr int CS_LAYER = 44 + 32;
constexpr int TR_LAYER = CS_LAYER + TR_WOUT + TR_WUQ + TR_WUKV;
constexpr int Q8_LAYER = TR_WIN + TR_WQ;
DI void colscale_item(const Params& p, int l, int t, char* lds) {
    const bool isq = t >= 44;
    const int strip = isq ? t - 44 : t, N = isq ? 2048 : PJ;
    const float* src = isq ? p.in[18] + (size_t)l * D * 2048 : p.in[8] + (size_t)l * D * PJ;
    float* dst = isq ? (float*)(p.ws + OFF_SWQ) + l * 2048 : (float*)(p.ws + OFF_SWIN) + l * PJP;
    const int tid = ltid(), c = strip * 64 + (tid & 63), ks = tid >> 6;
    float am = 0.f;
    if (c < N) { for (int k = ks * 256; k < ks * 256 + 256; ++k) am = fmaxf(am, fabsf(src[(size_t)k * N + c])); }
    float* red = (float*)lds;
    __syncthreads();
    red[tid] = am;
    __syncthreads();
    if (tid < 64) { am = fmaxf(fmaxf(red[tid], red[64 + tid]), fmaxf(red[128 + tid], red[192 + tid])); dst[c] = am > 0.f ? am * (1.f / 127.f) : 1.f; }
}
DI void transpose_q8_tile(const float* __restrict__ src, int N, unsigned char* __restrict__ dst, const float* __restrict__ scale, int kt, int nt, char* lds) {
    float* tl = (float*)lds;
    const int tid = ltid();
    __syncthreads();
#pragma unroll
    for (int i = 0; i < 4; ++i) {
        const int c = tid + 256 * i, kr = c >> 4, nc = (c & 15) * 4;
        const int k = kt * 64 + kr, n = nt * 64 + nc;
        f32x4 v = {0.f, 0.f, 0.f, 0.f};
        if (n < N) { v = *(const f32x4*)(src + (size_t)k * N + n); const f32x4 sc = *(const f32x4*)(scale + n); v[0] /= sc[0]; v[1] /= sc[1]; v[2] /= sc[2]; v[3] /= sc[3]; }
        tl[kr * 65 + nc + 0] = v[0]; tl[kr * 65 + nc + 1] = v[1]; tl[kr * 65 + nc + 2] = v[2]; tl[kr * 65 + nc + 3] = v[3];
    }
    __syncthreads();
    {
        const int nr = tid >> 2, kc = (tid & 3) * 16;
        u32x4 o;
#pragma unroll
        for (int q = 0; q < 4; ++q) {
            unsigned pk = 0u;
#pragma unroll
            for (int e = 0; e < 4; ++e) pk |= ((unsigned)__float2int_rn(tl[(kc + 4 * q + e) * 65 + nr]) & 255u) << (8 * e);
            o[q] = pk;
        }
        *(u32x4*)(dst + (size_t)(nt * 64 + nr) * D + kt * 64 + kc) = o;
    }
}
DI void q8_item(const Params& p, int item, char* lds) {
    const int l = item / Q8_LAYER; int t = item % Q8_LAYER;
    if (t < TR_WIN) transpose_q8_tile(p.in[8] + (size_t)l * D * PJ, PJ, (unsigned char*)(p.ws + OFF_WIN) + (size_t)l * PJP * D, (const float*)(p.ws + OFF_SWIN) + l * PJP, t / 44, t % 44, lds);
    else { t -= TR_WIN; transpose_q8_tile(p.in[18] + (size_t)l * D * 2048, 2048, (unsigned char*)(p.ws + OFF_WQ) + (size_t)l * 2048 * D, (const float*)(p.ws + OFF_SWQ) + l * 2048, t / 32, t % 32, lds); }
}

constexpr int TAB_ITEMS = 2 * NEXP / 64;
constexpr int P0_ADA = 192;
constexpr int P0_TR = 2 * TR_LAYER;
constexpr int P0_KEYS = 2 * 32;
constexpr int P0_ROWS = 2 * 2 * NEXP / 4;
constexpr int P0_TOTAL = P0_ADA + P0_TR + P0_KEYS + P0_ROWS;

DI void table_fp8_item(const Params& p, int item) {
    const int lane = ltid() & 63, w = ltid() >> 6;
    const int rid = item * 4 + w;
    const int layer = rid / (2 * NEXP), tb = (rid / NEXP) & 1, row = rid % NEXP;
    const float* src = (tb == 0 ? p.in[20] : p.in[21]) + ((size_t)layer * NEXP + row) * D + 16 * lane;
    f32x4 v[4];
#pragma unroll
    for (int i = 0; i < 4; ++i) v[i] = *(const f32x4*)(src + 4 * i);
    float am = 0.f;
#pragma unroll
    for (int i = 0; i < 4; ++i)
#pragma unroll
        for (int e = 0; e < 4; ++e) am = fmaxf(am, fabsf(v[i][e]));
#pragma unroll
    for (int o = 32; o > 0; o >>= 1) am = fmaxf(am, shx(am, o, lane));
    const float sc = am > 0.f ? am * (1.f / 127.f) : 1.f;
    const float inv = 1.f / sc;
    u32x4 o;
#pragma unroll
    for (int i = 0; i < 4; ++i) {
        unsigned pk = 0u;
#pragma unroll
        for (int e = 0; e < 4; ++e) pk |= ((unsigned)__float2int_rn(v[i][e] * inv) & 255u) << (8 * e);
        o[i] = pk;
    }
    unsigned char* dst = (unsigned char*)(p.ws + (tb == 0 ? OFF_PU : OFF_PV)) + (size_t)layer * NEXP * D + (size_t)(lane >> 3) * NEXP * 128 + (size_t)row * 128 + 16 * (lane & 7);
    *(u32x4*)dst = o;
    if (lane == 0) ((float*)(p.ws + OFF_PSC))[(size_t)(layer * 2 + tb) * NEXP + row] = sc;
}
DI void table_item(const Params& p, int layer, int it) { for (int q = 0; q < 16; ++q) table_fp8_item(p, (layer * TAB_ITEMS + it) * 16 + q); }

DI void phase0_item(const Params& p, int item, char* lds) {
    if (item < P0_ADA) { adaln_item(p, item, lds); return; }
    item -= P0_ADA;
    if (item < P0_TR) {
        const int l = item / TR_LAYER; int t = item % TR_LAYER;
        if (t < CS_LAYER) { colscale_item(p, l, t, lds); return; }
        t -= CS_LAYER;
        if (t < TR_WOUT) { transpose_tile(p.in[17] + (size_t)l * D * D, D, D, (bf16_t*)(p.ws + OFF_WOUT) + (size_t)l * D * D, nullptr, t / 16, t % 16, lds); return; }
        t -= TR_WOUT;
        if (t < TR_WUQ) { transpose_tile(p.in[13] + (size_t)l * 256 * 384, 256, 384, (bf16_t*)(p.ws + OFF_WUQ) + (size_t)l * 384 * 256, p.in[12] + l * 256, t / 6, t % 6, lds); return; }
        t -= TR_WUQ;
        transpose_tile(p.in[15] + (size_t)l * 128 * 512, 128, 512, (bf16_t*)(p.ws + OFF_WUKV) + (size_t)l * 512 * 128, p.in[14] + l * 128, t / 8, t % 8, lds);
        return;
    }
    item -= P0_TR;
    if (item < P0_KEYS) { const int l = item / 32; convert_item(p.in[19] + (size_t)l * 262144, (bf16_t*)(p.ws + OFF_KEYS) + (size_t)l * 262144, item % 32); return; }
    item -= P0_KEYS;
    table_fp8_item(p, item);
}

DI void load_row16(const float* __restrict__ row, int lane, f32x4 (&v)[4]) {
#pragma unroll
    for (int i = 0; i < 4; ++i) v[i] = *(const f32x4*)(row + 4 * lane + 256 * i);
}
DI float wave_sum(float s, int lane) {
#pragma unroll
    for (int o = 32; o > 0; o >>= 1) s += shx(s, o, lane);
    return s;
}
DI float row_rstd(const f32x4 (&v)[4], int lane) {
    float s = 0.f;
#pragma unroll
    for (int i = 0; i < 4; ++i) s += v[i][0] * v[i][0] + v[i][1] * v[i][1] + v[i][2] * v[i][2] + v[i][3] * v[i][3];
    s = wave_sum(s, lane);
    return rsqrtf(s * (1.f / 1024.f) + EPS);
}
DI void norm_mod_store(const f32x4 (&v)[4], float rstd, const float* __restrict__ g, const float* __restrict__ sc, const float* __restrict__ sh, bf16_t* __restrict__ orow, int lane) {
#pragma unroll
    for (int i = 0; i < 4; ++i) {
        const int c = 4 * lane + 256 * i;
        const f32x4 gv = *(const f32x4*)(g + c), scv = *(const f32x4*)(sc + c), shv = *(const f32x4*)(sh + c);
        f32x4 y;
#pragma unroll
        for (int e = 0; e < 4; ++e) y[e] = fmaf(v[i][e] * rstd * gv[e], 1.f + scv[e], shv[e]);
        u32x2 o; o[0] = pk2(y[0], y[1]); o[1] = pk2(y[2], y[3]);
        *(u32x2*)(orow + c) = o;
    }
}

DI void phase_norm(const Params& p, int layer, int which, bool from_input) {
    const int lane = ltid() & 63;
    const int gw = blockIdx.x * 4 + (ltid() >> 6), nw = gridDim.x * 4;
    const float* g = (which == 0 ? p.in[4] : p.in[5]) + layer * 1024;
    for (int n = gw; n < NTOK; n += nw) {
        const float* row = from_input ? xin_row(p, 0, n) : xcur_row(p, n);
        f32x4 v[4]; load_row16(row, lane, v);
        const float rstd = row_rstd(v, lane);
        const float* mv = mod_vec(p, layer, n) + which * 3072;
        {
            f32x4 y[4]; float am = 0.f;
#pragma unroll
            for (int i = 0; i < 4; ++i) {
                const int c = 4 * lane + 256 * i;
                const f32x4 gv = *(const f32x4*)(g + c), scv = *(const f32x4*)(mv + 1024 + c), shv = *(const f32x4*)(mv + c);
#pragma unroll
                for (int e = 0; e < 4; ++e) { y[i][e] = fmaf(v[i][e] * rstd * gv[e], 1.f + scv[e], shv[e]); am = fmaxf(am, fabsf(y[i][e])); }
            }
#pragma unroll
            for (int o = 32; o > 0; o >>= 1) am = fmaxf(am, shx(am, o, lane));
            const float sc = am > 0.f ? am * (1.f / 127.f) : 1.f, inv = 1.f / sc;
            unsigned char* xq = (unsigned char*)(p.ws + (which == 1 ? OFF_XQ : OFF_HQ)) + (size_t)n * D;
#pragma unroll
            for (int i = 0; i < 4; ++i) {
                unsigned pk = 0u;
#pragma unroll
                for (int e = 0; e < 4; ++e) pk |= ((unsigned)__float2int_rn(y[i][e] * inv) & 255u) << (8 * e);
                *(unsigned*)(xq + 4 * lane + 256 * i) = pk;
            }
            if (lane == 0) ((float*)(p.ws + (which == 1 ? OFF_SXQ : OFF_SH)))[n] = sc;
        }
    }
}
constexpr int G_LD = 72;
constexpr int G_TILE = 128 * G_LD * 2;
constexpr int G_STAGE = 2 * G_TILE;
constexpr int G_LDS = 2 * G_STAGE;

typedef __attribute__((address_space(3))) char lchar_t;
typedef __attribute__((address_space(1))) const char gchar_t;
constexpr int GD_TILE = 128 * 128;
constexpr int GD_STAGE = 2 * GD_TILE;
template <int TRANS>
DI void gemm128(const bf16_t* __restrict__ A, int lda, const bf16_t* __restrict__ Bt, int ldb, int K, char* lds, f32x16 (&acc)[2][2], bool rt_trans = false, bool probe = false) {
    const int tid = ltid(), lane = tid & 63, w = tid >> 6, wr = w >> 1, wc = w & 1;
    const int r = lane & 31, h = lane >> 5;
    const int drow = 8 * w + (lane >> 3), dc = (lane & 7) ^ ((drow >> 1) & 7);
    const bf16_t* ap = A + (size_t)drow * lda + dc * 8;
    const bf16_t* bp = Bt + (size_t)drow * ldb + dc * 8;
    lchar_t* l3 = (lchar_t*)lds + (8 * w) * 128;
    const int swz = (r >> 1) & 7;
    (void)probe;
#pragma unroll
    for (int i = 0; i < 2; ++i)
#pragma unroll
        for (int j = 0; j < 2; ++j)
#pragma unroll
            for (int e = 0; e < 16; ++e) acc[i][j][e] = 0.f;
    const int KT = K >> 6;
#define G_DMA(stage_, kt_) { const int ko_ = (kt_) * 64; _Pragma("unroll") for (int j = 0; j < 4; ++j) {                                   \
        __builtin_amdgcn_global_load_lds((gchar_t*)(ap + (size_t)(32 * j) * lda + ko_), l3 + (stage_) * GD_STAGE + (32 * j) * 128, 16, 0, 0);           \
        __builtin_amdgcn_global_load_lds((gchar_t*)(bp + (size_t)(32 * j) * ldb + ko_), l3 + (stage_) * GD_STAGE + GD_TILE + (32 * j) * 128, 16, 0, 0); } }
    __syncthreads();
    G_DMA(0, 0);
    for (int kt = 0; kt < KT; ++kt) {
        asm volatile("s_waitcnt vmcnt(0)" ::: "memory");
        __syncthreads();
        if (kt + 1 < KT) G_DMA((kt + 1) & 1, kt + 1);
        const char* cur = lds + (kt & 1) * GD_STAGE;
#pragma unroll
        for (int ks = 0; ks < 4; ++ks) {
            bf16x8 af[2], bfr[2];
            const int co = ((ks * 2 + h) ^ swz) * 16;
#pragma unroll
            for (int i = 0; i < 2; ++i) af[i] = *(const bf16x8*)(cur + (wr * 64 + i * 32 + r) * 128 + co);
#pragma unroll
            for (int j = 0; j < 2; ++j) bfr[j] = *(const bf16x8*)(cur + GD_TILE + (wc * 64 + j * 32 + r) * 128 + co);
#pragma unroll
            for (int i = 0; i < 2; ++i)
#pragma unroll
                for (int j = 0; j < 2; ++j) {
                    if (TRANS == 1) acc[i][j] = MFMA32(bfr[j], af[i], acc[i][j]);
                    else if (TRANS == 0) acc[i][j] = MFMA32(af[i], bfr[j], acc[i][j]);
                    else { const bf16x8 x = rt_trans ? bfr[j] : af[i], y = rt_trans ? af[i] : bfr[j]; acc[i][j] = MFMA32(x, y, acc[i][j]); }
                }
        }
    }
    __syncthreads();
#undef G_DMA
}

typedef int i32x4 __attribute__((ext_vector_type(4)));
typedef int i32x16 __attribute__((ext_vector_type(16)));
DI void gemm128_i8(const unsigned char* __restrict__ A, int lda, const unsigned char* __restrict__ Bt, int ldb, int K, char* lds, i32x16 (&acc)[2][2]) {
    const int tid = ltid(), lane = tid & 63, w = tid >> 6, wr = w >> 1, wc = w & 1;
    const int r = lane & 31, h = lane >> 5;
    const int drow = 8 * w + (lane >> 3), dc = (lane & 7) ^ ((drow >> 1) & 7);
    const unsigned char* ap = A + (size_t)drow * lda + dc * 16;
    const unsigned char* bp = Bt + (size_t)drow * ldb + dc * 16;
    lchar_t* l3 = (lchar_t*)lds + (8 * w) * 128;
    const int swz = (r >> 1) & 7;
#pragma unroll
    for (int i = 0; i < 2; ++i)
#pragma unroll
        for (int j = 0; j < 2; ++j)
#pragma unroll
            for (int e = 0; e < 16; ++e) acc[i][j][e] = 0;
    const int KT = K >> 7;
#define G_DMA8(stage_, kt_) { const int ko_ = (kt_) * 128; _Pragma("unroll") for (int j = 0; j < 4; ++j) {                                   \
        __builtin_amdgcn_global_load_lds((gchar_t*)(ap + (size_t)(32 * j) * lda + ko_), l3 + (stage_) * GD_STAGE + (32 * j) * 128, 16, 0, 0);           \
        __builtin_amdgcn_global_load_lds((gchar_t*)(bp + (size_t)(32 * j) * ldb + ko_), l3 + (stage_) * GD_STAGE + GD_TILE + (32 * j) * 128, 16, 0, 0); } }
    __syncthreads();
    G_DMA8(0, 0);
    for (int kt = 0; kt < KT; ++kt) {
        asm volatile("s_waitcnt vmcnt(0)" ::: "memory");
        __syncthreads();
        if (kt + 1 < KT) G_DMA8((kt + 1) & 1, kt + 1);
        const char* cur = lds + (kt & 1) * GD_STAGE;
#pragma unroll
        for (int ks = 0; ks < 4; ++ks) {
            i32x4 af[2], bfr[2];
            const int co = ((ks * 2 + h) ^ swz) * 16;
#pragma unroll
            for (int i = 0; i < 2; ++i) af[i] = *(const i32x4*)(cur + (wr * 64 + i * 32 + r) * 128 + co);
#pragma unroll
            for (int j = 0; j < 2; ++j) bfr[j] = *(const i32x4*)(cur + GD_TILE + (wc * 64 + j * 32 + r) * 128 + co);
#pragma unroll
            for (int i = 0; i < 2; ++i)
#pragma unroll
                for (int j = 0; j < 2; ++j) acc[i][j] = __builtin_amdgcn_mfma_i32_32x32x32_i8(bfr[j], af[i], acc[i][j], 0, 0, 0);
        }
    }
    __syncthreads();
#undef G_DMA8
}

constexpr int P1_NT = PJP / 128;
constexpr int P1_ITEMS = (NTOK / 128) * P1_NT;
#ifndef PROBE_HOT
#define PROBE_HOT 0
#endif
DI void p1_item(const Params& p, int layer, int item, char* lds, bool rep = false) {
    const int mt = item / P1_NT, nt = item % P1_NT;
    const int m0 = (PROBE_HOT && rep) ? 0 : mt * 128, n0 = (PROBE_HOT && rep) ? 0 : nt * 128;
    i32x16 acci[2][2];
    gemm128_i8((const unsigned char*)(p.ws + OFF_HQ) + (size_t)m0 * D, D, (const unsigned char*)(p.ws + OFF_WIN) + (size_t)layer * PJP * D + (size_t)n0 * D, D, D, lds, acci);
    const int lane = ltid() & 63, w = ltid() >> 6, wr = w >> 1, wc = w & 1, r = lane & 31, h = lane >> 5;
    bf16_t* proj = (bf16_t*)(p.ws + ((PROBE_HOT && rep) ? OFF_QM : OFF_PROJ)) + ((PROBE_HOT && rep) ? (size_t)(item & 63) * 128 * PJ : 0);
    float* gates = (float*)(p.ws + ((PROBE_HOT && rep) ? OFF_QC : OFF_GATES));
    const float* sH = (const float*)(p.ws + OFF_SH);
    const float* sW = (const float*)(p.ws + OFF_SWIN) + layer * PJP;
    f32x16 acc[2][2];
#pragma unroll
    for (int i = 0; i < 2; ++i) {
        const float sa = sH[m0 + wr * 64 + i * 32 + r];
#pragma unroll
        for (int j = 0; j < 2; ++j)
#pragma unroll
            for (int g = 0; g < 4; ++g) {
                const int f = n0 + wc * 64 + j * 32 + 8 * g + 4 * h;
                f32x4 sb = {0.f, 0.f, 0.f, 0.f};
                if (f < PJ) sb = *(const f32x4*)(sW + f);
#pragma unroll
                for (int e = 0; e < 4; ++e) acc[i][j][4 * g + e] = (float)acci[i][j][4 * g + e] * (sa * sb[e]);
            }
    }
    bf16_t* T = (bf16_t*)lds;
#pragma unroll
    for (int i = 0; i < 2; ++i) {
        const int tl = wr * 64 + i * 32 + r, tok = m0 + tl;
#pragma unroll
        for (int j = 0; j < 2; ++j)
#pragma unroll
            for (int g = 0; g < 4; ++g) {
                const int fl = wc * 64 + j * 32 + 8 * g + 4 * h, f = n0 + fl;
                u32x2 o; o[0] = pk2(acc[i][j][4 * g], acc[i][j][4 * g + 1]); o[1] = pk2(acc[i][j][4 * g + 2], acc[i][j][4 * g + 3]);
                *(u32x2*)(T + tl * 136 + fl) = o;
                if (f >= C_MLG && f < C_MLG + 16) {
                    f32x4 gv = {acc[i][j][4 * g], acc[i][j][4 * g + 1], acc[i][j][4 * g + 2], acc[i][j][4 * g + 3]};
                    *(f32x4*)(gates + (size_t)tok * 16 + (f - C_MLG)) = gv;
                }
            }
    }
    __syncthreads();
    if (PROBE_VARIANT == 5 && rep) { if (T[ltid() * 3] == 0x1234) proj[ltid()] = 1; return; }
    {
        const int t2 = ltid();
#pragma unroll
        for (int i = 0; i < 8; ++i) {
            const int c = t2 + 256 * i, row = c >> 4, c8 = (c & 15) * 8;
            if (n0 + c8 < PJ) *(u32x4*)(proj + (size_t)(m0 + row) * PJ + n0 + c8) = *(const u32x4*)(T + row * 136 + c8);
        }
    }
}

constexpr int P5_ITEMS = (NTOK / 128) * 8;
DI void p5_item(const Params& p, int layer, int item, char* lds) {
    const int mt = item >> 3, nt = item & 7;
    const int m0 = mt * 128, n0 = nt * 128;
    f32x16 acc[2][2];
    gemm128<1>((const bf16_t*)(p.ws + OFF_ACT) + (size_t)m0 * D, D, (const bf16_t*)(p.ws + OFF_WOUT) + (size_t)layer * D * D + (size_t)n0 * D, D, D, lds, acc);
    const int lane = ltid() & 63, w = ltid() >> 6, wr = w >> 1, wc = w & 1, r = lane & 31, h = lane >> 5;
    float* T = (float*)lds;
#pragma unroll
    for (int i = 0; i < 2; ++i) {
        const int tl = wr * 64 + i * 32 + r;
#pragma unroll
        for (int j = 0; j < 2; ++j)
#pragma unroll
            for (int g = 0; g < 4; ++g) {
                f32x4 o = {acc[i][j][4 * g], acc[i][j][4 * g + 1], acc[i][j][4 * g + 2], acc[i][j][4 * g + 3]};
                *(f32x4*)(T + tl * 132 + wc * 64 + j * 32 + 8 * g + 4 * h) = o;
            }
    }
    __syncthreads();
    {
        const int t2 = ltid();
        f32x4 xv[16];
#pragma unroll
        for (int i = 0; i < 16; ++i) { const int c = t2 + 256 * i, row = c >> 5, c4 = (c & 31) * 4; xv[i] = __builtin_nontemporal_load((const f32x4*)(xin_row(p, layer, m0 + row) + n0 + c4)); }
        __builtin_amdgcn_sched_barrier(0);
#pragma unroll
        for (int i = 0; i < 16; ++i) {
            const int c = t2 + 256 * i, row = c >> 5, c4 = (c & 31) * 4, tok = m0 + row;
            const f32x4 a = *(const f32x4*)(T + row * 132 + c4);
            const f32x4 gv = *(const f32x4*)(mod_vec(p, layer, tok) + 2048 + n0 + c4);
            f32x4 o;
#pragma unroll
            for (int e = 0; e < 4; ++e) o[e] = fmaf(gv[e], a[e], xv[i][e]);
            __builtin_nontemporal_store(o, (f32x4*)(xcur_row(p, tok) + n0 + c4));
        }
    }
}
struct AttnJob {
    const bf16_t* Q; int ldq;
    const bf16_t* K; int ldk;
    const bf16_t* V; int ldv;
    bf16_t* O; int ldo;
    int r0b, r0e, r1b, r1e;
    int tq0;
    float scale2;
    float sink2; int has_sink;
    int probe;
};
#ifndef PROBE_VARIANT
#define PROBE_VARIANT 0
#endif
constexpr int ATT_STG = 22016;
constexpr int ATT_RPB = 2 * ATT_STG;

template <int DQ, bool VT, int MODE>
DI void attn_job(const AttnJob& J, char* lds) {
    constexpr int LDK = DQ + 8, KCH = DQ / 8, NKL = DQ / 32, KSB = 64 * LDK * 2;
    const int tid = ltid(), lane = tid & 63, w = tid >> 6, r = lane & 31, h = lane >> 5;
    const float* rpb = (const float*)(lds + ATT_RPB);
    bf16x8 qf[DQ / 16];
#pragma unroll
    for (int ks = 0; ks < DQ / 16; ++ks) qf[ks] = *(const bf16x8*)(J.Q + (size_t)(w * 32 + r) * J.ldq + ks * 16 + 8 * h);
    const int n0t = (J.r0e - J.r0b) >> 6, n1t = (J.r1e - J.r1b) >> 6, nt = n0t + n1t;
    const int tq = J.tq0 + w * 32 + r, tqw = J.tq0 + w * 32;
    const int qrow = tq >> 6, qcol = tq & 63;
    int rs = qrow - 4; rs = rs < 0 ? 0 : (rs > 248 ? 248 : rs);
    int cs = qcol - 8; cs = cs < 0 ? 0 : (cs > 48 ? 48 : cs);

    u32x4 kregA[NKL], vregA[2], kregB[NKL], vregB[2];
    int krow_[NKL], kkc[NKL];
#pragma unroll
    for (int i = 0; i < NKL; ++i) { const int c = tid + 256 * i; krow_[i] = c / KCH; kkc[i] = (c % KCH) * 8; }
    const int vrow = tid >> 3, vkc = (tid & 7) * 8;
    const int vkey = tid & 63, vc = tid >> 6;

#define ATT_GLOAD(kreg, vreg, pos_)                                                                                         \
    {                                                                                                           \
        _Pragma("unroll") for (int i = 0; i < NKL; ++i) kreg[i] = *(const u32x4*)(J.K + (size_t)((pos_) + krow_[i]) * J.ldk + kkc[i]); \
        if (VT) { _Pragma("unroll") for (int i = 0; i < 2; ++i) vreg[i] = *(const u32x4*)(J.V + (size_t)(vrow + 32 * i) * J.ldv + (pos_) + vkc); } \
        else { _Pragma("unroll") for (int i = 0; i < 2; ++i) vreg[i] = *(const u32x4*)(J.V + (size_t)((pos_) + vkey) * J.ldv + (vc + 4 * i) * 8); } \
    }
#define ATT_LSTORE(kreg, vreg, st_)                                                                                         \
    {                                                                                                           \
        _Pragma("unroll") for (int i = 0; i < NKL; ++i) *(u32x4*)((st_) + (krow_[i] * LDK + kkc[i]) * 2) = kreg[i]; \
        if (VT) { _Pragma("unroll") for (int i = 0; i < 2; ++i) {                                               \
            u32x2 a_ = {vreg[i][0], vreg[i][1]}, b_ = {vreg[i][2], vreg[i][3]};                                 \
            *(u32x2*)((st_) + KSB + ((vrow + 32 * i) * 68 + vkc) * 2) = a_;                                     \
            *(u32x2*)((st_) + KSB + ((vrow + 32 * i) * 68 + vkc + 4) * 2) = b_; } }                             \
        else { _Pragma("unroll") for (int i = 0; i < 2; ++i) { bf16_t* vb_ = (bf16_t*)((st_) + KSB) + (size_t)((vc + 4 * i) * 8) * 68 + vkey; \
            _Pragma("unroll") for (int e = 0; e < 4; ++e) { vb_[(2 * e) * 68] = (bf16_t)(vreg[i][e] & 0xffffu); vb_[(2 * e + 1) * 68] = (bf16_t)(vreg[i][e] >> 16); } } } \
    }

    f32x16 o0, o1, la;
#pragma unroll
    for (int e = 0; e < 16; ++e) { o0[e] = 0.f; o1[e] = 0.f; la[e] = 0.f; }
    float m = -1e30f;
    bf16x8 ones;
#pragma unroll
    for (int e = 0; e < 8; ++e) ones[e] = (short)0x3f80;
#define ATT_POS(i_) ((i_) < n0t ? J.r0b + 64 * (i_) : J.r1b + 64 * ((i_) - n0t))
    {
        ATT_GLOAD(kregA, vregA, ATT_POS(0));
        { const int i1_ = nt > 1 ? 1 : 0; ATT_GLOAD(kregB, vregB, ATT_POS(i1_)); }
        __syncthreads();
        ATT_LSTORE(kregA, vregA, lds);
        __builtin_amdgcn_s_waitcnt(0);
        __syncthreads();
    }
    for (int it0 = 0; it0 < nt; it0 += 2) {
#pragma unroll
      for (int par = 0; par < 2; ++par) {
        const int it = it0 + par;
        if (it >= nt) break;
        const int pos = ATT_POS(it);
        char* cur = lds + par * ATT_STG;
        { const int i2_ = it + 2 < nt ? it + 2 : nt - 1; const int np = ATT_POS(i2_);
          if (par == 0) { ATT_GLOAD(kregA, vregA, np); } else { ATT_GLOAD(kregB, vregB, np); } }
        __builtin_amdgcn_sched_barrier(0);
        const bool isctx = pos < CTXL;
        bool active = true;
        int key_row = 0;
        if (MODE == 1 && !isctx) { key_row = (pos - CTXL) >> 6; active = (key_row >= rs) && (key_row < rs + 8); }
        if (MODE == 2 && !isctx) { const int tk0 = pos - CTXL; active = (tk0 + 63 >= tqw - 128) && (tk0 <= tqw + 31 + 128); }
        if (active) {
            f32x16 s0, s1;
#pragma unroll
            for (int e = 0; e < 16; ++e) { s0[e] = 0.f; s1[e] = 0.f; }
            {
                bf16x8 kfa[DQ / 16], kfb[DQ / 16];
#pragma unroll
                for (int ks = 0; ks < DQ / 16; ++ks) {
                    kfa[ks] = *(const bf16x8*)(cur + (r * LDK + ks * 16 + 8 * h) * 2);
                    kfb[ks] = *(const bf16x8*)(cur + ((32 + r) * LDK + ks * 16 + 8 * h) * 2);
                }
                __builtin_amdgcn_sched_barrier(0);
                if (PROBE_VARIANT == 2 && J.probe) {
#pragma unroll
                    for (int e = 0; e < 8; ++e) { s0[e] = (float)kfa[0][e]; s1[e] = (float)kfb[0][e]; s0[8 + e] = (float)kfa[DQ / 16 - 1][e]; s1[8 + e] = (float)kfb[DQ / 16 - 1][e]; }
                } else {
#pragma unroll
                for (int ks = 0; ks < DQ / 16; ++ks) {
                    s0 = MFMA32(kfa[ks], qf[ks], s0);
                    s1 = MFMA32(kfb[ks], qf[ks], s1);
                }
                }
            }
            bf16x8 vfa[4], vfb[4];
            {
                const bf16_t* vb = (const bf16_t*)(cur + KSB);
#pragma unroll
                for (int st = 0; st < 4; ++st) {
                    const s16x4 lo0 = *(const s16x4*)(vb + r * 68 + 16 * st + 4 * h), hi0 = *(const s16x4*)(vb + r * 68 + 16 * st + 8 + 4 * h);
                    const s16x4 lo1 = *(const s16x4*)(vb + (32 + r) * 68 + 16 * st + 4 * h), hi1 = *(const s16x4*)(vb + (32 + r) * 68 + 16 * st + 8 + 4 * h);
                    vfa[st] = __builtin_shufflevector(lo0, hi0, 0, 1, 2, 3, 4, 5, 6, 7);
                    vfb[st] = __builtin_shufflevector(lo1, hi1, 0, 1, 2, 3, 4, 5, 6, 7);
                }
            }
            __builtin_amdgcn_sched_barrier(0);
            float mx = -1e30f;
            if (!(PROBE_VARIANT == 1 && J.probe)) {
            if (MODE == 1) {
#pragma unroll
                for (int e = 0; e < 16; ++e) {
                    float t0 = s0[e] * J.scale2, t1 = s1[e] * J.scale2;
                    if (!isctx) {
                        const int kc0 = crow(e, h), kc1 = 32 + crow(e, h);
                        const bool v0 = (kc0 >= cs) && (kc0 < cs + 16), v1 = (kc1 >= cs) && (kc1 < cs + 16);
                        const int rb = (key_row - qrow + 7) * 31 + 15 - qcol;
                        int i0 = rb + kc0, i1 = rb + kc1;
                        i0 = v0 ? i0 : 0; i1 = v1 ? i1 : 0;
                        t0 = v0 ? t0 + rpb[i0] : -1e30f;
                        t1 = v1 ? t1 + rpb[i1] : -1e30f;
                    }
                    s0[e] = t0; s1[e] = t1;
                    mx = fmax2(mx, fmax2(t0, t1));
                }
            } else {
#pragma unroll
                for (int e = 0; e < 16; ++e) {
                    if (MODE == 2 && !isctx) {
                        const int d0 = pos - CTXL + crow(e, h) - tq, d1 = d0 + 32;
                        s0[e] = (d0 <= 128 && d0 >= -128) ? s0[e] : -1e30f;
                        s1[e] = (d1 <= 128 && d1 >= -128) ? s1[e] : -1e30f;
                    }
                    mx = fmax2(mx, fmax2(s0[e], s1[e]));
                }
                mx *= J.scale2;
            }
            mx = fmax2(mx, shx(mx, 32, lane));
            const float mn = fmax2(m, mx);
            if (__builtin_amdgcn_ballot_w64(mn > m) != 0ull) {
                const float alpha = fexp2(m - mn);
#pragma unroll
                for (int e = 0; e < 16; ++e) { o0[e] *= alpha; o1[e] *= alpha; la[e] *= alpha; }
                m = mn;
            }
            if (MODE == 1) {
#pragma unroll
                for (int e = 0; e < 16; ++e) { s0[e] = fexp2(s0[e] - m); s1[e] = fexp2(s1[e] - m); }
            } else {
#pragma unroll
                for (int e = 0; e < 16; ++e) { s0[e] = fexp2(fmaf(s0[e], J.scale2, -m)); s1[e] = fexp2(fmaf(s1[e], J.scale2, -m)); }
            }
            }
            bf16x8 pf[4];
            {
                u32x4 t;
                t[0] = pk2(s0[0], s0[1]); t[1] = pk2(s0[2], s0[3]); t[2] = pk2(s0[4], s0[5]); t[3] = pk2(s0[6], s0[7]); pf[0] = __builtin_bit_cast(bf16x8, t);
                t[0] = pk2(s0[8], s0[9]); t[1] = pk2(s0[10], s0[11]); t[2] = pk2(s0[12], s0[13]); t[3] = pk2(s0[14], s0[15]); pf[1] = __builtin_bit_cast(bf16x8, t);
                t[0] = pk2(s1[0], s1[1]); t[1] = pk2(s1[2], s1[3]); t[2] = pk2(s1[4], s1[5]); t[3] = pk2(s1[6], s1[7]); pf[2] = __builtin_bit_cast(bf16x8, t);
                t[0] = pk2(s1[8], s1[9]); t[1] = pk2(s1[10], s1[11]); t[2] = pk2(s1[12], s1[13]); t[3] = pk2(s1[14], s1[15]); pf[3] = __builtin_bit_cast(bf16x8, t);
            }
            if (PROBE_VARIANT == 2 && J.probe) {
#pragma unroll
                for (int e = 0; e < 8; ++e) { o0[e] += (float)vfa[0][e] + (float)pf[0][e]; o1[e] += (float)vfb[3][e] + (float)pf[3][e]; o0[8 + e] += (float)vfa[1][e] + (float)pf[1][e]; o1[8 + e] += (float)vfb[2][e] + (float)pf[2][e]; }
            } else
#pragma unroll
            for (int st = 0; st < 4; ++st) {
                o0 = MFMA32(vfa[st], pf[st], o0);
                o1 = MFMA32(vfb[st], pf[st], o1);
                la = MFMA32(ones, pf[st], la);
            }
        }
        if (it + 1 < nt) { if (par == 0) { ATT_LSTORE(kregB, vregB, lds + ATT_STG); } else { ATT_LSTORE(kregA, vregA, lds); } }
        __syncthreads();
      }
    }
#undef ATT_GLOAD
#undef ATT_LSTORE
#undef ATT_POS
    float l = la[0];
    if (J.has_sink) l += fexp2(J.sink2 - m);
    const float inv = 1.f / l;
    bf16_t* orow = J.O + (size_t)(w * 32 + r) * J.ldo;
#pragma unroll
    for (int g = 0; g < 4; ++g) {
        u32x2 a; a[0] = pk2(o0[4 * g] * inv, o0[4 * g + 1] * inv); a[1] = pk2(o0[4 * g + 2] * inv, o0[4 * g + 3] * inv);
        *(u32x2*)(orow + 8 * g + 4 * h) = a;
        u32x2 b; b[0] = pk2(o1[4 * g] * inv, o1[4 * g + 1] * inv); b[1] = pk2(o1[4 * g + 2] * inv, o1[4 * g + 3] * inv);
        *(u32x2*)(orow + 32 + 8 * g + 4 * h) = b;
    }
}
typedef int i32x8 __attribute__((ext_vector_type(8)));
struct MlaJob { const unsigned char* Q; const unsigned char* K; const unsigned char* V; bf16_t* O; int ldo; int nkeys; };
constexpr int MX_STG = 8192 + 4096;
constexpr int MX_STG2 = 2 * MX_STG;
#define MFMA_MX(a, b, c) __builtin_amdgcn_mfma_scale_f32_32x32x64_f8f6f4((a), (b), (c), 0, 0, 0, 0x7f7f7f7f, 0, 0x7f7f7f7f)

DI void attn_mla_mx(const MlaJob& J, char* lds) {
    const int tid = ltid(), lane = tid & 63, w = tid >> 6, r = lane & 31, h = lane >> 5;
    i32x8 qf[2][2];
#pragma unroll
    for (int qs = 0; qs < 2; ++qs) {
        const unsigned char* qp = J.Q + (size_t)(w * 64 + qs * 32 + r) * 512 + 32 * h;
#pragma unroll
        for (int kb = 0; kb < 2; ++kb) {
            const u32x4 a = *(const u32x4*)(qp + 64 * kb), b = *(const u32x4*)(qp + 64 * kb + 16);
            qf[qs][kb][0] = a[0]; qf[qs][kb][1] = a[1]; qf[qs][kb][2] = a[2]; qf[qs][kb][3] = a[3]; qf[qs][kb][4] = b[0]; qf[qs][kb][5] = b[1]; qf[qs][kb][6] = b[2]; qf[qs][kb][7] = b[3];
        }
    }
    __builtin_amdgcn_s_waitcnt(0);
    __syncthreads();
    float c0 = -64.f, c1 = -64.f;
    if (h) { qf[0][1][0] = 0x68; qf[1][1][0] = 0x68; }
    const int krow = 8 * w + (lane >> 3), kc = (lane & 7) ^ ((krow >> 1) & 7);
    const unsigned char* kp = J.K + (size_t)krow * 128 + kc * 16;
    const int vrow = 16 * w + (lane >> 2), vc = (lane & 3) ^ ((vrow >> 2) & 3);
    const unsigned char* vp = J.V + (size_t)vrow * P + vc * 16;
    lchar_t* l3 = (lchar_t*)lds;
#define MX_DMA1(base_, pos_) {                                                                                                          \
        __builtin_amdgcn_global_load_lds((gchar_t*)(kp + (size_t)(pos_) * 128), l3 + (base_) + (8 * w) * 128, 16, 0, 0);                 \
        __builtin_amdgcn_global_load_lds((gchar_t*)(kp + (size_t)((pos_) + 32) * 128), l3 + (base_) + (32 + 8 * w) * 128, 16, 0, 0);     \
        __builtin_amdgcn_global_load_lds((gchar_t*)(vp + (pos_)), l3 + (base_) + 8192 + (16 * w) * 64, 16, 0, 0); }
#define MX_DMA(stage_, pair_) { MX_DMA1((stage_) * MX_STG2, (pair_) * 128); MX_DMA1((stage_) * MX_STG2 + MX_STG, (pair_) * 128 + 64); }
    const int np = J.nkeys >> 7;
    MX_DMA(0, 0);
    { const int t1 = np > 1 ? 1 : np - 1; MX_DMA(1, t1); }
    f32x16 o0[2], o1[2];
    float l0 = 0.f, l1 = 0.f;
#pragma unroll
    for (int qs = 0; qs < 2; ++qs)
#pragma unroll
        for (int e = 0; e < 16; ++e) { o0[qs][e] = 0.f; o1[qs][e] = 0.f; }
    f32x16 zero16;
#pragma unroll
    for (int e = 0; e < 16; ++e) zero16[e] = 0.f;
    const int ksw = (r >> 1) & 7, vsw = (r >> 2) & 3;
#define FADD(a_, b_) ({ float r_; asm("v_add_f32_e32 %0, %1, %2" : "=v"(r_) : "v"(a_), "v"(b_)); r_; })
#define SBAR() __builtin_amdgcn_sched_barrier(0)
#define TILE_BASE(tile_) (lds + (((tile_) >> 1) % 3) * MX_STG2 + ((tile_) & 1) * MX_STG)
#define MX_KREAD(dst_, tile_, u_) {                                                                                                     \
        const char* rp = TILE_BASE(tile_) + (32 * (u_) + r) * 128;                                                                      \
        _Pragma("unroll") for (int kb = 0; kb < 2; ++kb) {                                                                              \
            const u32x4 a = *(const u32x4*)(rp + (((4 * kb + 2 * h) ^ ksw) * 16)), b = *(const u32x4*)(rp + (((4 * kb + 2 * h + 1) ^ ksw) * 16)); \
            dst_[kb][0] = a[0]; dst_[kb][1] = a[1]; dst_[kb][2] = a[2]; dst_[kb][3] = a[3]; dst_[kb][4] = b[0]; dst_[kb][5] = b[1]; dst_[kb][6] = b[2]; dst_[kb][7] = b[3]; } }
#define MX_VREAD(tile_) {                                                                                                               \
        _Pragma("unroll") for (int d = 0; d < 2; ++d) {                                                                                 \
            const char* rp = TILE_BASE(tile_) + 8192 + (32 * d + r) * 64;                                                               \
            const u32x4 a = *(const u32x4*)(rp + (((2 * h) ^ vsw) * 16)), b = *(const u32x4*)(rp + (((2 * h + 1) ^ vsw) * 16));         \
            vf[d][0] = a[0]; vf[d][1] = a[1]; vf[d][2] = a[2]; vf[d][3] = a[3]; vf[d][4] = b[0]; vf[d][5] = b[1]; vf[d][6] = b[2]; vf[d][7] = b[3]; } }
#define MX_PACK(S_, qs_, u_) {                                                                                                          \
        _Pragma("unroll") for (int g = 0; g < 4; ++g) {                                                                                 \
            int a = __builtin_amdgcn_cvt_pk_fp8_f32(S_[4 * g], S_[4 * g + 1], 0, false);                                                \
            a = __builtin_amdgcn_cvt_pk_fp8_f32(S_[4 * g + 2], S_[4 * g + 3], a, true); pf[qs_][4 * (u_) + g] = a; } }
#define KEEP(x_) asm volatile("" :: "v"(x_))
#define MX_EXP(S_, a_, b_) { _Pragma("unroll") for (int e = (a_); e < (b_); ++e) S_[e] = fexp2(S_[e]); }
#define MX_SUMCHECK(S_, qs_, u_, cq_, lq_) {                                                                                            \
        float a0 = FADD(S_[0], S_[4]), a1 = FADD(S_[1], S_[5]), a2 = FADD(S_[2], S_[6]), a3 = FADD(S_[3], S_[7]);     \
        a0 = FADD(a0, S_[8]); a1 = FADD(a1, S_[9]); a2 = FADD(a2, S_[10]); a3 = FADD(a3, S_[11]);                                       \
        a0 = FADD(a0, S_[12]); a1 = FADD(a1, S_[13]); a2 = FADD(a2, S_[14]); a3 = FADD(a3, S_[15]);                                     \
        a0 = FADD(a0, a2); a1 = FADD(a1, a3);                                                                                           \
        float ts = FADD(a0, a1);                                                                                                        \
        if (__builtin_amdgcn_ballot_w64(ts > 128.f) != 0ull) {                                                                          \
            const float tf = ts + shx(ts, 32, lane);                                 \
            const bool bad = tf > 64.f;                                                                                                 \
            const float tg = -(cq_ + __builtin_amdgcn_logf(tf) - 4.f);                           \
            const int e1 = __builtin_amdgcn_cvt_pk_fp8_f32(tg, 0.f, 0, false);                                                          \
            const float d1 = __builtin_amdgcn_cvt_f32_fp8(e1, 0);                                                                       \
            const int e2 = __builtin_amdgcn_cvt_pk_fp8_f32(tg, tg - d1, 0, false);                                                      \
            const float cn = -(d1 + __builtin_amdgcn_cvt_f32_fp8(e2, 1));                                                               \
            const float f = bad ? fexp2(cq_ - cn) : 1.f;                                                                                \
            cq_ = bad ? cn : cq_; lq_ *= f; ts *= f;                                                                                    \
            if (h && bad) qf[qs_][1][0] = e2 & 0xffff;                                                                                  \
            _Pragma("unroll") for (int e = 0; e < 16; ++e) { o0[qs_][e] *= f; o1[qs_][e] *= f; S_[e] *= f; }                            \
            if ((u_) == 1) {                                           \
                _Pragma("unroll") for (int g = 0; g < 4; ++g) {                                                                         \
                    const int pw = pf[qs_][g];                                                                                          \
                    int a = __builtin_amdgcn_cvt_pk_fp8_f32(__builtin_amdgcn_cvt_f32_fp8(pw, 0) * f, __builtin_amdgcn_cvt_f32_fp8(pw, 1) * f, 0, false); \
                    a = __builtin_amdgcn_cvt_pk_fp8_f32(__builtin_amdgcn_cvt_f32_fp8(pw, 2) * f, __builtin_amdgcn_cvt_f32_fp8(pw, 3) * f, a, true);      \
                    pf[qs_][g] = a; } }                                                                                                 \
        }                                                                                                                               \
        lq_ += ts; }
    const int nt = 2 * np;
    asm volatile("s_waitcnt vmcnt(6) lgkmcnt(0)" ::: "memory");
    __builtin_amdgcn_s_barrier();
    { const int t2 = 2 < np ? 2 : np - 1; MX_DMA(2, t2); }
    i32x8 kfa[2], kfb[2];
    i32x8 vf[2], pf[2];
    f32x16 SA, SB;
#pragma unroll
    for (int e = 0; e < 16; ++e) SB[e] = 0.f;
#pragma unroll
    for (int e = 0; e < 8; ++e) { vf[0][e] = 0; vf[1][e] = 0; pf[0][e] = 0; pf[1][e] = 0; }
    MX_KREAD(kfa, 0, 0);
    MX_KREAD(kfb, 0, 1);
    SA = MFMA_MX(kfa[0], qf[0][0], zero16); SA = MFMA_MX(kfa[1], qf[0][1], SA);
#pragma unroll 1
    for (int t = 0; t < nt; ++t) {
        MX_PACK(SB, 1, 1);
        SBAR();
        o0[1] = MFMA_MX(vf[0], pf[1], o0[1]); KEEP(o0[1]);
        SBAR();
        MX_EXP(SA, 0, 6);
        SBAR();
        SB = MFMA_MX(kfa[0], qf[1][0], zero16); KEEP(SB);
        SBAR();
        MX_EXP(SA, 6, 12);
        SBAR();
        o1[1] = MFMA_MX(vf[1], pf[1], o1[1]); KEEP(o1[1]);
        SBAR();
        MX_EXP(SA, 12, 16);
        SBAR();
        SB = MFMA_MX(kfa[1], qf[1][1], SB); KEEP(SB);
        SBAR();
        MX_SUMCHECK(SA, 0, 0, c0, l0);
        SBAR();
        MX_PACK(SA, 0, 0);
        SBAR();
        SA = MFMA_MX(kfb[0], qf[0][0], zero16); KEEP(SA);
        MX_VREAD(t);
        SBAR();
        MX_EXP(SB, 0, 8);
        SBAR();
        SA = MFMA_MX(kfb[1], qf[0][1], SA); KEEP(SA);
        SBAR();
        MX_EXP(SB, 8, 16);
        MX_SUMCHECK(SB, 1, 0, c1, l1);
        SBAR();
        if ((t & 1) && t + 1 < nt) {
            asm volatile("s_waitcnt vmcnt(6) lgkmcnt(0)" ::: "memory");
            __builtin_amdgcn_s_barrier();
            const int ip3 = (t >> 1) + 3;
            { const int t2 = ip3 < np ? ip3 : np - 1; MX_DMA(ip3 % 3, t2); }
        }
        MX_KREAD(kfa, t + 1, 0);
        SBAR();
        MX_PACK(SB, 1, 0);
        SBAR();
        SB = MFMA_MX(kfb[0], qf[1][0], zero16); KEEP(SB);
        SBAR();
        MX_EXP(SA, 0, 8);
        SBAR();
        SB = MFMA_MX(kfb[1], qf[1][1], SB); KEEP(SB);
        SBAR();
        MX_EXP(SA, 8, 16);
        MX_SUMCHECK(SA, 0, 1, c0, l0);
        SBAR();
        MX_PACK(SA, 0, 1);
        SBAR();
        o0[0] = MFMA_MX(vf[0], pf[0], o0[0]); KEEP(o0[0]);
        MX_KREAD(kfb, t + 1, 1);
        SBAR();
        MX_EXP(SB, 0, 6);
        SBAR();
        SA = MFMA_MX(kfa[0], qf[0][0], zero16); KEEP(SA);
        SBAR();
        MX_EXP(SB, 6, 12);
        SBAR();
        o1[0] = MFMA_MX(vf[1], pf[0], o1[0]); KEEP(o1[0]);
        SBAR();
        MX_EXP(SB, 12, 16);
        SBAR();
        SA = MFMA_MX(kfa[1], qf[0][1], SA); KEEP(SA);
        SBAR();
        MX_SUMCHECK(SB, 1, 1, c1, l1);
        SBAR();
    }
    MX_PACK(SB, 1, 1);
    o0[1] = MFMA_MX(vf[0], pf[1], o0[1]);
    o1[1] = MFMA_MX(vf[1], pf[1], o1[1]);
    asm volatile("s_waitcnt vmcnt(0)" ::: "memory");
    const int tid2 = ltid(), lane2 = tid2 & 63, w2 = tid2 >> 6, r2 = lane2 & 31, h2 = lane2 >> 5;
    l0 += shx(l0, 32, lane2); l1 += shx(l1, 32, lane2);
#undef MX_DMA
#undef MX_DMA1
#undef MX_KREAD
#undef MX_VREAD
#undef MX_PACK
#undef MX_EXP
#undef MX_SUMCHECK
#undef KEEP
#undef TILE_BASE
#undef SBAR
#undef FADD
#pragma unroll
    for (int qs = 0; qs < 2; ++qs) {
        const float inv = 1.f / (qs ? l1 : l0);
        bf16_t* orow = J.O + (size_t)(w2 * 64 + qs * 32 + r2) * J.ldo;
#pragma unroll
        for (int g = 0; g < 4; ++g) {
            u32x2 a; a[0] = pk2(o0[qs][4 * g] * inv, o0[qs][4 * g + 1] * inv); a[1] = pk2(o0[qs][4 * g + 2] * inv, o0[qs][4 * g + 3] * inv);
            *(u32x2*)(orow + 8 * g + 4 * h2) = a;
            u32x2 b; b[0] = pk2(o1[qs][4 * g] * inv, o1[qs][4 * g + 1] * inv); b[1] = pk2(o1[qs][4 * g + 2] * inv, o1[qs][4 * g + 3] * inv);
            *(u32x2*)(orow + 32 + 8 * g + 4 * h2) = b;
        }
    }
}
constexpr int P2_MQ = (NTOK / 128) * 3, P2_MKV = (NTOK / 128) * 4, P2_ROPE = NB * T * 12 / 256, P2_ML = NB * 4 * NCH;
constexpr int P2_ITEMS = P2_MQ + P2_MKV + P2_ROPE + P2_ML;
constexpr int RS_OFF = G_LDS;

constexpr float INV8[8] = {1.f, 0.316227766f, 0.1f, 0.0316227766f, 0.01f, 0.00316227766f, 0.001f, 0.000316227766f};
constexpr float INV16[16] = {1.f, 0.562341325f, 0.316227766f, 0.177827941f, 0.1f, 0.0562341325f, 0.0316227766f, 0.0177827941f,
                             0.01f, 0.00562341325f, 0.00316227766f, 0.00177827941f, 0.001f, 0.000562341325f, 0.000316227766f, 0.000177827941f};

DI void rows_rstd(const bf16_t* __restrict__ A, int lda, int ncol, float* rsd) {
    const int tid = ltid(), row = tid >> 1, half = tid & 1;
    const int per = ncol >> 1;
    const bf16_t* a = A + (size_t)row * lda + half * per;
    float s = 0.f;
    for (int c = 0; c < per; c += 8) {
        const u32x4 v = *(const u32x4*)(a + c);
#pragma unroll
        for (int e = 0; e < 4; ++e) { const float x = bflo(v[e]), y = bfhi(v[e]); s = fmaf(x, x, s); s = fmaf(y, y, s); }
    }
    s += shx(s, 1, tid & 63);
    if (half == 0) rsd[row] = rsqrtf(s / (float)ncol + EPS);
}

DI void p2_mla_q(const Params& p, int layer, int item, char* lds) {
    const int mt = item / 3, nt = item % 3, m0 = mt * 128, n0 = nt * 128;
    const bf16_t* A = (const bf16_t*)(p.ws + OFF_PROJ) + (size_t)m0 * PJ + C_CQ;
    float* rsd = (float*)(lds + RS_OFF);
    __syncthreads();
    rows_rstd(A, PJ, 256, rsd);
    f32x16 acc[2][2];
    gemm128<1>(A, PJ, (const bf16_t*)(p.ws + OFF_WUQ) + (size_t)layer * 384 * 256 + (size_t)n0 * 256, 256, 256, lds, acc);
    const int lane = ltid() & 63, w = ltid() >> 6, wr = w >> 1, wc = w & 1, r = lane & 31, h = lane >> 5;
    unsigned char* Qm8 = (unsigned char*)(p.ws + OFF_QM);
#pragma unroll
    for (int i = 0; i < 2; ++i) {
        const int tl = wr * 64 + i * 32 + r, tok = m0 + tl;
        const float rs = rsd[tl] * (0.10206207261596577f * LOG2E);
        const int b = tok_b(tok), pos = tok - b * P;
#pragma unroll
        for (int j = 0; j < 2; ++j) {
            const int u = (n0 + wc * 64 + j * 32) >> 5, head = u / 3, part = u % 3;
            float v[16];
#pragma unroll
            for (int e = 0; e < 16; ++e) v[e] = acc[i][j][e] * rs;
            if (part == 2 && pos >= CTXL) {
                const int t = pos - CTXL;
                const float frow = (float)(t >> 6), fcol = (float)(t & 63);
#pragma unroll
                for (int e = 0; e < 4; ++e) {
                    const float inv = h ? INV8[4 + e] : INV8[e];
                    float s, c;
                    sincos_cw(frow * inv, s, c);
                    const float x1 = v[e], x2 = v[4 + e];
                    v[e] = x1 * c - x2 * s; v[4 + e] = x1 * s + x2 * c;
                    sincos_cw(fcol * inv, s, c);
                    const float y1 = v[8 + e], y2 = v[12 + e];
                    v[8 + e] = y1 * c - y2 * s; v[12 + e] = y1 * s + y2 * c;
                }
            }
            unsigned char* dst = Qm8 + ((size_t)tok * 4 + head) * 128 + part * 32;
#pragma unroll
            for (int g = 0; g < 4; ++g) {
                int pk = __builtin_amdgcn_cvt_pk_fp8_f32(v[4 * g], v[4 * g + 1], 0, false);
                pk = __builtin_amdgcn_cvt_pk_fp8_f32(v[4 * g + 2], v[4 * g + 3], pk, true);
                *(int*)(dst + 8 * g + 4 * h) = pk;
            }
            if (part == 2 && h == 0) { const u32x4 z = {0u, 0u, 0u, 0u}; *(u32x4*)(dst + 32) = z; *(u32x4*)(dst + 48) = z; }
        }
    }
}

DI void p2_mla_kv(const Params& p, int layer, int item, char* lds) {
    const int mt = item >> 2, head = item & 3, m0 = mt * 128;
    const bf16_t* proj = (const bf16_t*)(p.ws + OFF_PROJ);
    const bf16_t* A = proj + (size_t)m0 * PJ + C_CKV;
    float* rsd = (float*)(lds + RS_OFF);
    __syncthreads();
    rows_rstd(A, PJ, 128, rsd);
    const int lane = ltid() & 63, w = ltid() >> 6, wr = w >> 1, wc = w & 1, r = lane & 31, h = lane >> 5;
    f32x16 acc[2][2];
    gemm128<2>(A, PJ, (const bf16_t*)(p.ws + OFF_WUKV) + (size_t)layer * 512 * 128 + (size_t)head * 128 * 128, 128, 128, lds, acc, wc == 0);
    const int b = tok_b(m0), pos_base = m0 - b * P;
    unsigned char* Km = (unsigned char*)(p.ws + OFF_KM) + (size_t)(b * 4 + head) * P * 128;
    unsigned char* Vt = (unsigned char*)(p.ws + OFF_VTM) + (size_t)(b * 4 + head) * 64 * P;
    if (wc == 0) {
#pragma unroll
        for (int i = 0; i < 2; ++i) {
            const int tl = wr * 64 + i * 32 + r;
            const float rs = rsd[tl];
            unsigned char* dst = Km + (size_t)(pos_base + tl) * 128;
#pragma unroll
            for (int j = 0; j < 2; ++j)
#pragma unroll
                for (int g = 0; g < 4; ++g) {
                    int pk = __builtin_amdgcn_cvt_pk_fp8_f32(acc[i][j][4 * g] * rs, acc[i][j][4 * g + 1] * rs, 0, false);
                    pk = __builtin_amdgcn_cvt_pk_fp8_f32(acc[i][j][4 * g + 2] * rs, acc[i][j][4 * g + 3] * rs, pk, true);
                    *(int*)(dst + j * 32 + 8 * g + 4 * h) = pk;
                }
        }
    } else {
#pragma unroll
        for (int i = 0; i < 2; ++i)
#pragma unroll
            for (int j = 0; j < 2; ++j) {
                const int dv = j * 32 + r;
#pragma unroll
                for (int g = 0; g < 4; ++g) {
                    const int tl = wr * 64 + i * 32 + 8 * g + 4 * h;
                    const f32x4 rv = *(const f32x4*)(rsd + tl);
                    int pk = __builtin_amdgcn_cvt_pk_fp8_f32(acc[i][j][4 * g] * rv[0], acc[i][j][4 * g + 1] * rv[1], 0, false);
                    pk = __builtin_amdgcn_cvt_pk_fp8_f32(acc[i][j][4 * g + 2] * rv[2], acc[i][j][4 * g + 3] * rv[3], pk, true);
                    *(int*)(Vt + (size_t)dv * P + pos_base + wr * 64 + 32 * h + 16 * i + 4 * g) = pk;
                }
            }
    }
    {
        const int tl = ltid() >> 1, part = ltid() & 1;
        const int pos = pos_base + tl;
        const bf16_t* src = proj + (size_t)(m0 + tl) * PJ + C_KR + 16 * part;
        const u32x4 a = *(const u32x4*)src, bq = *(const u32x4*)(src + 8);
        float x1[8], x2[8];
#pragma unroll
        for (int e = 0; e < 4; ++e) { x1[2 * e] = bflo(a[e]); x1[2 * e + 1] = bfhi(a[e]); x2[2 * e] = bflo(bq[e]); x2[2 * e + 1] = bfhi(bq[e]); }
        if (pos >= CTXL) {
            const int t = pos - CTXL;
            const float fp = part == 0 ? (float)(t >> 6) : (float)(t & 63);
#pragma unroll
            for (int e = 0; e < 8; ++e) {
                float s, c;
                sincos_cw(fp * INV8[e], s, c);
                const float u1 = x1[e], u2 = x2[e];
                x1[e] = u1 * c - u2 * s; x2[e] = u1 * s + u2 * c;
            }
        }
        u32x4 o;
#pragma unroll
        for (int e = 0; e < 2; ++e) {
            int a_ = __builtin_amdgcn_cvt_pk_fp8_f32(x1[4 * e], x1[4 * e + 1], 0, false); a_ = __builtin_amdgcn_cvt_pk_fp8_f32(x1[4 * e + 2], x1[4 * e + 3], a_, true);
            int b_ = __builtin_amdgcn_cvt_pk_fp8_f32(x2[4 * e], x2[4 * e + 1], 0, false); b_ = __builtin_amdgcn_cvt_pk_fp8_f32(x2[4 * e + 2], x2[4 * e + 3], b_, true);
            o[e] = (unsigned)a_; o[2 + e] = (unsigned)b_;
        }
        unsigned char* dst = Km + (size_t)pos * 128 + 64 + 16 * part;
        *(u32x4*)dst = o;
        const u32x4 z = {part == 0 ? 0x3838u : 0u, 0u, 0u, 0u};
        *(u32x4*)(dst + 32) = z;
    }
}

DI void p2_rope(const Params& p, int item) {
    const int gid = item * 256 + ltid();
    const int tokl = gid / 12, rem = gid % 12, slot = rem >> 1, part = rem & 1;
    const int b = tokl / T, t = tokl % T;
    const int n = b * P + CTXL + t;
    bf16_t* base = (bf16_t*)(p.ws + OFF_PROJ) + (size_t)n * PJ + (slot < 4 ? C_SWQ + slot * 64 : C_SWK + (slot - 4) * 64) + part * 32;
    const float fp = part == 0 ? (float)(t >> 6) : (float)(t & 63);
    u32x4 a0 = *(const u32x4*)base, a1 = *(const u32x4*)(base + 8), b0 = *(const u32x4*)(base + 16), b1 = *(const u32x4*)(base + 24);
    float x1[16], x2[16];
#pragma unroll
    for (int e = 0; e < 4; ++e) {
        x1[2 * e] = bflo(a0[e]); x1[2 * e + 1] = bfhi(a0[e]); x1[8 + 2 * e] = bflo(a1[e]); x1[8 + 2 * e + 1] = bfhi(a1[e]);
        x2[2 * e] = bflo(b0[e]); x2[2 * e + 1] = bfhi(b0[e]); x2[8 + 2 * e] = bflo(b1[e]); x2[8 + 2 * e + 1] = bfhi(b1[e]);
    }
#pragma unroll
    for (int e = 0; e < 16; ++e) {
        float s, c;
        sincos_cw(fp * INV16[e], s, c);
        const float u1 = x1[e], u2 = x2[e];
        x1[e] = u1 * c - u2 * s; x2[e] = u1 * s + u2 * c;
    }
#pragma unroll
    for (int e = 0; e < 4; ++e) {
        a0[e] = pk2(x1[2 * e], x1[2 * e + 1]); a1[e] = pk2(x1[8 + 2 * e], x1[8 + 2 * e + 1]);
        b0[e] = pk2(x2[2 * e], x2[2 * e + 1]); b1[e] = pk2(x2[8 + 2 * e], x2[8 + 2 * e + 1]);
    }
    *(u32x4*)base = a0; *(u32x4*)(base + 8) = a1; *(u32x4*)(base + 16) = b0; *(u32x4*)(base + 24) = b1;
}
DI int ml_order(int dir, int i) { return dir == 0 ? i : (i < 4 ? 3 - i : 263 - i); }
constexpr int ML_LD = 72;

DI void p2_mlstm(const Params& p, int layer, int item, char* lds) {
    const int b = item / (4 * NCH), hh = (item / NCH) & 3, c = item % NCH;
    const int tid = ltid(), lane = tid & 63, w = tid >> 6, r = lane & 31, h = lane >> 5;
    const int pos0 = c * 64, seg_lo = c < 4 ? 0 : CTXL, seg_hi = c < 4 ? CTXL : P;
    const int nbase = b * P + pos0;
    bf16_t* KT = (bf16_t*)lds;
    bf16_t* VWf = KT + 64 * ML_LD;
    bf16_t* VWb = VWf + 64 * ML_LD;
    float* cw = (float*)(VWb + 64 * ML_LD);
    float* wkf = cw + 640;
    float* wkb = wkf + 64;
    const bf16_t* proj = (const bf16_t*)(p.ws + OFF_PROJ);
    __syncthreads();
    for (int i = tid; i < 640; i += 256) {
        const int j = i >> 7, cc = i & 127;
        cw[i] = p.in[10][(size_t)layer * 5 * 512 + j * 512 + (cc < 64 ? hh * 64 + cc : 256 + hh * 64 + (cc - 64))];
    }
    if (w == 0) {
        const int n = nbase + lane;
        const float* gp = (const float*)(p.ws + OFF_GATES) + (size_t)n * 16;
        const float* gb = p.in[11] + layer * 16;
        const float i_f = gp[hh] + gb[hh], f_f = gp[4 + hh] + gb[4 + hh], i_b = gp[8 + hh] + gb[8 + hh], f_b = gp[12 + hh] + gb[12 + hh];
        float bf_ = logsigmoidf_(f_f), bb_ = logsigmoidf_(f_b);
#pragma unroll
        for (int o = 1; o < 64; o <<= 1) {
            const float uf = shfrom(bf_, lane >= o ? lane - o : lane), ub = shfrom(bb_, lane + o < 64 ? lane + o : lane);
            if (lane >= o) bf_ += uf;
            if (lane + o < 64) bb_ += ub;
        }
        const float Ff = shfrom(bf_, 63), Fb = shfrom(bb_, 0);
        const float gf = Ff - bf_ + i_f, gbw = Fb - bb_ + i_b;
        float mgf = gf, mgb = gbw;
#pragma unroll
        for (int o = 32; o > 0; o >>= 1) { mgf = fmaxf(mgf, shx(mgf, o, lane)); mgb = fmaxf(mgb, shx(mgb, o, lane)); }
        wkf[lane] = fexp(gf - mgf); wkb[lane] = fexp(gbw - mgb);
        float* GB = (float*)(p.ws + OFF_GB);
        f32x2 v0 = {bf_, i_f}, v1 = {bb_, i_b};
        *(f32x2*)(GB + ((size_t)(0 * NTOK + n) * 4 + hh) * 2) = v0;
        *(f32x2*)(GB + ((size_t)(1 * NTOK + n) * 4 + hh) * 2) = v1;
        if (lane == 0) {
            float* META = (float*)(p.ws + OFF_META);
            const int ch0 = 0 * 8 + b * 4 + hh, ch1 = 8 + b * 4 + hh;
            META[((size_t)ch0 * NCH + c) * 4 + 0] = Ff; META[((size_t)ch0 * NCH + c) * 4 + 1] = mgf;
            META[((size_t)ch1 * NCH + c) * 4 + 0] = Fb; META[((size_t)ch1 * NCH + c) * 4 + 1] = mgb;
        }
    }
    __syncthreads();
    bf16_t* QC = (bf16_t*)(p.ws + OFF_QC);
    bf16_t* KC = (bf16_t*)(p.ws + OFF_KC);
#pragma unroll
    for (int i = 0; i < 4; ++i) {
        const int u = tid + 256 * i, s = u & 63, grp = u >> 6;
        const int col = (grp < 8 ? C_MLQ + hh * 64 + grp * 8 : C_MLK + hh * 64 + (grp - 8) * 8);
        const int cwo = (grp < 8 ? grp * 8 : 64 + (grp - 8) * 8);
        float a[8];
#pragma unroll
        for (int e = 0; e < 8; ++e) a[e] = 0.f;
#pragma unroll
        for (int j = 0; j < 5; ++j) {
            const int pos = pos0 + s + j - 2;
            if (pos >= seg_lo && pos < seg_hi) {
                const u32x4 v = *(const u32x4*)(proj + (size_t)(b * P + pos) * PJ + col);
#pragma unroll
                for (int e = 0; e < 4; ++e) { a[2 * e] = fmaf(bflo(v[e]), cw[j * 128 + cwo + 2 * e], a[2 * e]); a[2 * e + 1] = fmaf(bfhi(v[e]), cw[j * 128 + cwo + 2 * e + 1], a[2 * e + 1]); }
            }
        }
#pragma unroll
        for (int e = 0; e < 8; ++e) a[e] = siluf(a[e]) * (grp < 8 ? 0.125f : 1.f);
        u32x4 o; o[0] = pk2(a[0], a[1]); o[1] = pk2(a[2], a[3]); o[2] = pk2(a[4], a[5]); o[3] = pk2(a[6], a[7]);
        if (grp < 8) *(u32x4*)(QC + (size_t)(nbase + s) * 256 + hh * 64 + grp * 8) = o;
        else {
            *(u32x4*)(KC + (size_t)(nbase + s) * 256 + hh * 64 + (grp - 8) * 8) = o;
#pragma unroll
            for (int e = 0; e < 4; ++e) { KT[((grp - 8) * 8 + 2 * e) * ML_LD + s] = (bf16_t)(o[e] & 0xffffu); KT[((grp - 8) * 8 + 2 * e + 1) * ML_LD + s] = (bf16_t)(o[e] >> 16); }
        }
    }
#pragma unroll
    for (int i = 0; i < 2; ++i) {
        const int u = tid + 256 * i, s = u & 63, grp = u >> 6;
        const u32x4 v = *(const u32x4*)(proj + (size_t)(nbase + s) * PJ + C_MLV + hh * 64 + grp * 8);
        const float wf = wkf[s], wb = wkb[s];
#pragma unroll
        for (int e = 0; e < 4; ++e) {
            const float x = bflo(v[e]), y = bfhi(v[e]);
            VWf[(grp * 8 + 2 * e) * ML_LD + s] = f2bf(x * wf); VWf[(grp * 8 + 2 * e + 1) * ML_LD + s] = f2bf(y * wf);
            VWb[(grp * 8 + 2 * e) * ML_LD + s] = f2bf(x * wb); VWb[(grp * 8 + 2 * e + 1) * ML_LD + s] = f2bf(y * wb);
        }
    }
    __syncthreads();
    {
        const int dir = w >> 1, dkt = w & 1;
        const bf16_t* VW = dir ? VWb : VWf;
        f32x16 u0, u1;
#pragma unroll
        for (int e = 0; e < 16; ++e) { u0[e] = 0.f; u1[e] = 0.f; }
#pragma unroll
        for (int ks = 0; ks < 4; ++ks) {
            const bf16x8 a = *(const bf16x8*)(KT + (dkt * 32 + r) * ML_LD + ks * 16 + 8 * h);
            const bf16x8 b0 = *(const bf16x8*)(VW + (r) * ML_LD + ks * 16 + 8 * h);
            const bf16x8 b1 = *(const bf16x8*)(VW + (32 + r) * ML_LD + ks * 16 + 8 * h);
            u0 = MFMA32(a, b0, u0);
            u1 = MFMA32(a, b1, u1);
        }
        const int chain = dir * 8 + b * 4 + hh;
        bf16_t* UB = (bf16_t*)(p.ws + OFF_UB) + ((size_t)chain * NCH + c) * 4096;
#pragma unroll
        for (int g = 0; g < 4; ++g) {
            u32x2 o; o[0] = pk2(u0[4 * g], u0[4 * g + 1]); o[1] = pk2(u0[4 * g + 2], u0[4 * g + 3]);
            *(u32x2*)(UB + (size_t)(r) * 64 + dkt * 32 + 8 * g + 4 * h) = o;
            u32x2 q; q[0] = pk2(u1[4 * g], u1[4 * g + 1]); q[1] = pk2(u1[4 * g + 2], u1[4 * g + 3]);
            *(u32x2*)(UB + (size_t)(32 + r) * 64 + dkt * 32 + 8 * g + 4 * h) = q;
        }
    }
    if (tid < 128) {
        const int dir = tid >> 6, dk = tid & 63;
        const float* wk = dir ? wkb : wkf;
        float s = 0.f;
#pragma unroll 8
        for (int t = 0; t < 64; ++t) s = fmaf(wk[t], bf2f(KT[dk * ML_LD + t]), s);
        const int chain = dir * 8 + b * 4 + hh;
        ((float*)(p.ws + OFF_UN))[((size_t)chain * NCH + c) * 64 + dk] = s;
    }
}

constexpr int P3_SCAN = 16 * 2080 / 256;
DI void p3_scan(const Params& p, int item) {
    const int gid = item * 256 + ltid();
    const int chain = gid / 2080, e2 = gid % 2080, dir = chain >> 3;
    const float* META = (const float*)(p.ws + OFF_META) + (size_t)chain * NCH * 4;
    float* METAw = (float*)(p.ws + OFF_META) + (size_t)chain * NCH * 4;
    const bool is_mat = e2 < 2048;
    unsigned* UBm = (unsigned*)((bf16_t*)(p.ws + OFF_UB) + (size_t)chain * NCH * 4096) + (is_mat ? e2 : 0);
    f32x2* UNm = (f32x2*)((float*)(p.ws + OFF_UN) + (size_t)chain * NCH * 64) + (is_mat ? 0 : e2 - 2048);
    float s0 = 0.f, s1 = 0.f, m = 0.f;
    constexpr int SB = 4;
    for (int i0 = 0; i0 < NCH; i0 += SB) {
        float u0[SB], u1[SB], F[SB], mg[SB]; int cc[SB];
#pragma unroll
        for (int k = 0; k < SB; ++k) {
            cc[k] = ml_order(dir, i0 + k);
            F[k] = META[cc[k] * 4 + 0]; mg[k] = META[cc[k] * 4 + 1];
            if (is_mat) { const unsigned v = UBm[(size_t)cc[k] * 2048]; u0[k] = bflo(v); u1[k] = bfhi(v); }
            else { const f32x2 v = UNm[(size_t)cc[k] * 32]; u0[k] = v[0]; u1[k] = v[1]; }
        }
#pragma unroll
        for (int k = 0; k < SB; ++k) {
            if (is_mat) UBm[(size_t)cc[k] * 2048] = pk2(s0, s1);
            else { f32x2 v = {s0, s1}; UNm[(size_t)cc[k] * 32] = v; }
            if (e2 == 0) METAw[cc[k] * 4 + 2] = m;
            const float mn = fmaxf(F[k] + m, mg[k]);
            const float dec = fexp(F[k] + m - mn), sc = fexp(mg[k] - mn);
            s0 = fmaf(dec, s0, sc * u0[k]); s1 = fmaf(dec, s1, sc * u1[k]);
            m = mn;
        }
    }
}

constexpr int P4_ITEMS = NB * 4 * NCH;
DI void p4_mlstm_out(const Params& p, int layer, int item, char* lds) {
    const int b = item / (4 * NCH), hh = (item / NCH) & 3, c = item % NCH;
    const int tid = ltid(), lane = tid & 63, w = tid >> 6, r = lane & 31, h = lane >> 5;
    const int nbase = b * P + c * 64;
    bf16_t* Qs = (bf16_t*)lds;
    bf16_t* Ks = Qs + 64 * ML_LD;
    bf16_t* Cs = Ks + 64 * ML_LD;
    bf16_t* Vt = Cs + 2 * 64 * ML_LD;
    float* nv = (float*)(Vt + 64 * 68);
    float* bg = nv + 128;
    float* dd = bg + 128;
    float* mp = dd + 128;
    float* X = mp + 4;
    const bf16_t* proj = (const bf16_t*)(p.ws + OFF_PROJ);
    __syncthreads();
    {
        const bf16_t* QC = (const bf16_t*)(p.ws + OFF_QC) + (size_t)nbase * 256 + hh * 64;
        const bf16_t* KC = (const bf16_t*)(p.ws + OFF_KC) + (size_t)nbase * 256 + hh * 64;
#pragma unroll
        for (int i = 0; i < 2; ++i) {
            const int cidx = tid + 256 * i, row = cidx >> 3, kc = (cidx & 7) * 8;
            *(u32x4*)(Qs + row * ML_LD + kc) = *(const u32x4*)(QC + (size_t)row * 256 + kc);
            *(u32x4*)(Ks + row * ML_LD + kc) = *(const u32x4*)(KC + (size_t)row * 256 + kc);
#pragma unroll
            for (int d = 0; d < 2; ++d) {
                const int chain = d * 8 + b * 4 + hh;
                const bf16_t* UB = (const bf16_t*)(p.ws + OFF_UB) + ((size_t)chain * NCH + c) * 4096;
                *(u32x4*)(Cs + (d * 64 + row) * ML_LD + kc) = *(const u32x4*)(UB + row * 64 + kc);
            }
            const int key = tid & 63, vc = (tid >> 6) + 4 * i;
            const u32x4 v = *(const u32x4*)(proj + (size_t)(nbase + key) * PJ + C_MLV + hh * 64 + vc * 8);
#pragma unroll
            for (int e = 0; e < 4; ++e) { Vt[(vc * 8 + 2 * e) * 68 + key] = (bf16_t)(v[e] & 0xffffu); Vt[(vc * 8 + 2 * e + 1) * 68 + key] = (bf16_t)(v[e] >> 16); }
        }
        if (tid < 128) {
            const int d = tid >> 6, s = tid & 63, chain = d * 8 + b * 4 + hh;
            nv[tid] = ((const float*)(p.ws + OFF_UN))[((size_t)chain * NCH + c) * 64 + s];
            const f32x2 g = *(const f32x2*)((const float*)(p.ws + OFF_GB) + ((size_t)(d * NTOK + nbase + s) * 4 + hh) * 2);
            bg[tid] = g[0]; dd[tid] = g[1] - g[0];
            if (s == 0) mp[d] = ((const float*)(p.ws + OFF_META))[((size_t)chain * NCH + c) * 4 + 2];
        }
    }
    __syncthreads();
    const int dir = w >> 1, tt = w & 1;
    const int t = tt * 32 + r;
    const float bt = bg[dir * 64 + t], mprev = mp[dir];
    bf16x8 qf[4];
#pragma unroll
    for (int ks = 0; ks < 4; ++ks) qf[ks] = *(const bf16x8*)(Qs + t * ML_LD + ks * 16 + 8 * h);
    f32x16 sa[2];
    float mt = bt + mprev;
#pragma unroll
    for (int st = 0; st < 2; ++st) {
        const bool skip = dir == 0 ? (st > tt) : (st < tt);
#pragma unroll
        for (int e = 0; e < 16; ++e) sa[st][e] = 0.f;
        if (!skip) {
#pragma unroll
            for (int ks = 0; ks < 4; ++ks) {
                const bf16x8 kf = *(const bf16x8*)(Ks + (st * 32 + r) * ML_LD + ks * 16 + 8 * h);
                sa[st] = MFMA32(kf, qf[ks], sa[st]);
            }
        }
    }
    float dl[2][16];
#pragma unroll
    for (int st = 0; st < 2; ++st)
#pragma unroll
        for (int e = 0; e < 16; ++e) {
            const int s = st * 32 + crow(e, h);
            const bool valid = dir == 0 ? (s <= t) : (s >= t);
            const float v = valid ? bt + dd[dir * 64 + s] : -1e30f;
            dl[st][e] = v;
            mt = fmaxf(mt, v);
        }
    mt = fmaxf(mt, shx(mt, 32, lane));
    float rsum = 0.f;
#pragma unroll
    for (int st = 0; st < 2; ++st)
#pragma unroll
        for (int e = 0; e < 16; ++e) { const float wgt = fexp(dl[st][e] - mt); sa[st][e] *= wgt; rsum += sa[st][e]; }
    rsum += shx(rsum, 32, lane);
    const float at = fexp(bt + mprev - mt);
    float qn = 0.f;
#pragma unroll 8
    for (int k = 0; k < 32; ++k) qn = fmaf(bf2f(Qs[t * ML_LD + 32 * h + k]), nv[dir * 64 + 32 * h + k], qn);
    qn += shx(qn, 32, lane);
    bf16x8 pf[4];
    {
        u32x4 tq;
#pragma unroll
        for (int st = 0; st < 2; ++st) {
            tq[0] = pk2(sa[st][0], sa[st][1]); tq[1] = pk2(sa[st][2], sa[st][3]); tq[2] = pk2(sa[st][4], sa[st][5]); tq[3] = pk2(sa[st][6], sa[st][7]); pf[2 * st] = __builtin_bit_cast(bf16x8, tq);
            tq[0] = pk2(sa[st][8], sa[st][9]); tq[1] = pk2(sa[st][10], sa[st][11]); tq[2] = pk2(sa[st][12], sa[st][13]); tq[3] = pk2(sa[st][14], sa[st][15]); pf[2 * st + 1] = __builtin_bit_cast(bf16x8, tq);
        }
    }
    f32x16 on[2], oi[2];
#pragma unroll
    for (int dv = 0; dv < 2; ++dv) {
#pragma unroll
        for (int e = 0; e < 16; ++e) { on[dv][e] = 0.f; oi[dv][e] = 0.f; }
#pragma unroll
        for (int st = 0; st < 4; ++st) {
            const s16x4 lo = *(const s16x4*)(Vt + (dv * 32 + r) * 68 + 16 * st + 4 * h), hi = *(const s16x4*)(Vt + (dv * 32 + r) * 68 + 16 * st + 8 + 4 * h);
            const bf16x8 vf = __builtin_shufflevector(lo, hi, 0, 1, 2, 3, 4, 5, 6, 7);
            on[dv] = MFMA32(vf, pf[st], on[dv]);
        }
#pragma unroll
        for (int ks = 0; ks < 4; ++ks) {
            const bf16x8 cf = *(const bf16x8*)(Cs + (dir * 64 + dv * 32 + r) * ML_LD + ks * 16 + 8 * h);
            oi[dv] = MFMA32(cf, qf[ks], oi[dv]);
        }
    }
    const float den = rsum + at * qn;
    const float invd = 1.f / fmaxf(fabsf(den), fexp(-mt));
    if (dir == 1) {
#pragma unroll
        for (int dv = 0; dv < 2; ++dv)
#pragma unroll
            for (int e = 0; e < 16; ++e) X[t * 65 + dv * 32 + crow(e, h)] = (on[dv][e] + at * oi[dv][e]) * invd;
    }
    __syncthreads();
    if (dir == 0) {
        const int n = nbase + t;
        bf16_t* y = (bf16_t*)(p.ws + OFF_ACT) + (size_t)n * D + 256 + hh * 64;
        const bf16_t* mo = proj + (size_t)n * PJ + C_MLO + hh * 64;
#pragma unroll
        for (int dv = 0; dv < 2; ++dv)
#pragma unroll
            for (int g = 0; g < 4; ++g) {
                const int d0 = dv * 32 + 8 * g + 4 * h;
                const u32x2 ov = *(const u32x2*)(mo + d0);
                const float og[4] = {bflo(ov[0]), bfhi(ov[0]), bflo(ov[1]), bfhi(ov[1])};
                float res[4];
#pragma unroll
                for (int e = 0; e < 4; ++e) res[e] = ((on[dv][4 * g + e] + at * oi[dv][4 * g + e]) * invd + X[t * 65 + d0 + e]) * sigmoidf_(og[e]);
                u32x2 o; o[0] = pk2(res[0], res[1]); o[1] = pk2(res[2], res[3]);
                *(u32x2*)(y + d0) = o;
            }
    }
}
DI unsigned f2ord(float f) { const unsigned u = __float_as_uint(f); return (u & 0x80000000u) ? ~u : (u | 0x80000000u); }
DI float ord2f(unsigned u) { return __uint_as_float((u & 0x80000000u) ? (u & 0x7fffffffu) : ~u); }
DI void cex(unsigned& a, unsigned& b, bool desc) { const unsigned mx = a > b ? a : b, mn = a > b ? b : a; a = desc ? mx : mn; b = desc ? mn : mx; }

DI void sort_runs16(unsigned (&k)[64]) {
#pragma unroll
    for (int size = 2; size <= 16; size <<= 1)
#pragma unroll
        for (int stride = size >> 1; stride > 0; stride >>= 1)
#pragma unroll
            for (int i = 0; i < 64; ++i) {
                const int j = i ^ stride;
                if (j > i) cex(k[i], k[j], (i & size) == 0);
            }
}
DI void merge16(unsigned (&a)[16], bool desc) {
#pragma unroll
    for (int stride = 8; stride > 0; stride >>= 1)
#pragma unroll
        for (int i = 0; i < 16; ++i) {
            const int j = i ^ stride;
            if (j > i) cex(a[i], a[j], desc);
        }
}
DI void top16_of_64(unsigned (&k)[64], unsigned (&out)[16]) {
    sort_runs16(k);
    unsigned a[16], b[16];
#pragma unroll
    for (int i = 0; i < 16; ++i) { a[i] = k[i] > k[16 + i] ? k[i] : k[16 + i]; b[i] = k[32 + i] > k[48 + i] ? k[32 + i] : k[48 + i]; }
    merge16(a, true);
    merge16(b, false);
#pragma unroll
    for (int i = 0; i < 16; ++i) out[i] = a[i] > b[i] ? a[i] : b[i];
    merge16(out, true);
}

constexpr int P7_ITEMS = (NTOK / 128) * 8;
constexpr int QY_LD = 136;
constexpr int P7_LST = G_LDS;
constexpr int P7_TAB = G_LDS + 4096;

DI void p7_item(const Params& p, int layer, int item, char* lds) {
    const int mt = item >> 3, head = item & 7, m0 = mt * 128;
#define P7_IDS const int tid = ltid(), lane = tid & 63, w = tid >> 6, wr = w >> 1, wc = w & 1, r = lane & 31, h = lane >> 5; (void)wr; (void)wc; (void)lane; (void)r; (void)h;
    unsigned char* lst = (unsigned char*)(lds + P7_LST);
    unsigned char* tab = (unsigned char*)(lds + P7_TAB);
    bf16_t* Qy = (bf16_t*)lds;
    bf16_t* Ky = Qy + 128 * QY_LD;
    unsigned* LSTG = (unsigned*)(p.ws + OFF_LSTG);
    __syncthreads();
    { P7_IDS
    if (tid < 64) {
        int cid = 0; unsigned char v = 0;
        for (int i = 0; i < 16; ++i) { const int nj = 16 / (i + 1); if (tid >= cid && tid < cid + nj) v = (unsigned char)((i << 4) | (tid - cid)); cid += nj; }
        tab[tid] = v;
    } }
#pragma unroll 1
    for (int pp = 0; pp < 2; ++pp) {
        const int hp = head * 2 + pp;
        __builtin_amdgcn_sched_barrier(0);
        i32x16 acc[2][2];
        gemm128_i8((const unsigned char*)(p.ws + OFF_XQ) + (size_t)m0 * D, D, (const unsigned char*)(p.ws + OFF_WQ) + (size_t)layer * 2048 * D + (size_t)hp * 128 * D, D, D, lds, acc);
        __builtin_amdgcn_sched_barrier(0);
        P7_IDS
#pragma unroll
        for (int i = 0; i < 2; ++i)
#pragma unroll
            for (int j = 0; j < 2; ++j)
#pragma unroll
                for (int g = 0; g < 4; ++g) {
                    const float sa = ((const float*)(p.ws + OFF_SXQ))[m0 + wr * 64 + i * 32 + r];
                    const f32x4 sb = *(const f32x4*)((const float*)(p.ws + OFF_SWQ) + layer * 2048 + hp * 128 + wc * 64 + j * 32 + 8 * g + 4 * h);
                    u32x2 o; o[0] = pk2((float)acc[i][j][4 * g] * (sa * sb[0]), (float)acc[i][j][4 * g + 1] * (sa * sb[1])); o[1] = pk2((float)acc[i][j][4 * g + 2] * (sa * sb[2]), (float)acc[i][j][4 * g + 3] * (sa * sb[3]));
                    *(u32x2*)(Qy + (wr * 64 + i * 32 + r) * QY_LD + wc * 64 + j * 32 + 8 * g + 4 * h) = o;
                }
        {
            const bf16_t* keys = (const bf16_t*)(p.ws + OFF_KEYS) + (size_t)layer * 262144 + (size_t)hp * 16384;
#pragma unroll
            for (int i = 0; i < 8; ++i) {
                const int c = tid + 256 * i, row = c >> 4, kc = (c & 15) * 8;
                *(u32x4*)(Ky + row * QY_LD + kc) = *(const u32x4*)(keys + row * 128 + kc);
            }
        }
        __syncthreads();
        f32x16 sc[4];
#pragma unroll
        for (int nt = 0; nt < 4; ++nt)
#pragma unroll
            for (int e = 0; e < 16; ++e) sc[nt][e] = 0.f;
#pragma unroll
        for (int ks = 0; ks < 8; ++ks) {
            const bf16x8 qf = *(const bf16x8*)(Qy + (w * 32 + r) * QY_LD + ks * 16 + 8 * h);
#pragma unroll
            for (int nt = 0; nt < 4; ++nt) {
                const bf16x8 kf = *(const bf16x8*)(Ky + (nt * 32 + r) * QY_LD + ks * 16 + 8 * h);
                sc[nt] = MFMA32(kf, qf, sc[nt]);
            }
        }
        __builtin_amdgcn_sched_barrier(0);
        unsigned k[64];
#pragma unroll
        for (int nt = 0; nt < 4; ++nt)
#pragma unroll
            for (int e = 0; e < 16; ++e) k[nt * 16 + e] = (f2ord(sc[nt][e]) & ~127u) | (unsigned)(127 - (nt * 32 + crow(e, h)));
        unsigned R[16];
        top16_of_64(k, R);
        __builtin_amdgcn_sched_barrier(0);
        unsigned F[16];
#pragma unroll
        for (int i = 0; i < 16; ++i) { const unsigned o = shxu(R[15 - i], 32, lane); F[i] = R[i] > o ? R[i] : o; }
        merge16(F, true);
        if (h == 0) {
#pragma unroll
            for (int i = 0; i < 16; ++i) lst[(w * 32 + r) * 32 + pp * 16 + i] = (unsigned char)(127 - (F[i] & 127u));
        }
        if (h == 0) {
            unsigned* dst = LSTG + ((size_t)(m0 + w * 32 + r) * 16 + hp) * 16;
#pragma unroll
            for (int q = 0; q < 4; ++q) { u32x4 v = {F[4 * q], F[4 * q + 1], F[4 * q + 2], F[4 * q + 3]}; *(u32x4*)(dst + 4 * q) = v; }
        }
    }
    asm volatile("s_waitcnt vmcnt(0)" ::: "memory");
    __syncthreads();
    P7_IDS
    unsigned L0[16], L1[16];
    {
        const unsigned* src = LSTG + ((size_t)(m0 + w * 32 + r) * 16 + head * 2) * 16;
#pragma unroll
        for (int q = 0; q < 4; ++q) {
            const u32x4 a = *(const u32x4*)(src + 4 * q), b = *(const u32x4*)(src + 16 + 4 * q);
#pragma unroll
            for (int e = 0; e < 4; ++e) { L0[4 * q + e] = a[e]; L1[4 * q + e] = b[e]; }
        }
    }
    __builtin_amdgcn_sched_barrier(0);
    float s0[16], s1[16];
#pragma unroll
    for (int i = 0; i < 16; ++i) { s0[i] = ord2f(L0[i] & ~127u); s1[i] = ord2f(L1[i] & ~127u); }
    unsigned ck[64];
    {
        int cid = 0;
#pragma unroll
        for (int i = 0; i < 16; ++i)
#pragma unroll
            for (int j = 0; j < 16; ++j)
                if ((i + 1) * (j + 1) <= 16) { ck[cid] = (f2ord(s0[i] + s1[j]) & ~63u) | (unsigned)(63 - cid); ++cid; }
#pragma unroll
        for (int q = 50; q < 64; ++q) ck[q] = 0u;
    }
    __builtin_amdgcn_sched_barrier(0);
    unsigned W[16];
    top16_of_64(ck, W);
    __builtin_amdgcn_sched_barrier(0);
    __syncthreads();
    const int tl = w * 32 + r, tok = m0 + tl;
    float fs[16]; int ei[16];
#pragma unroll
    for (int q = 0; q < 16; ++q) {
        const int cid = 63 - (int)(W[q] & 63u);
        const int ij = tab[cid];
        const int i0 = lst[tl * 32 + (ij >> 4)], i1 = lst[tl * 32 + 16 + (ij & 15)];
        ei[q] = i0 * 128 + i1;
        fs[q] = ord2f(W[q] & ~63u);
    }
    float sum = 0.f;
#pragma unroll
    for (int q = 0; q < 16; ++q) { fs[q] = fexp(fs[q] - ord2f(W[0] & ~63u)); sum += fs[q]; }
    const float inv = 1.f / sum;
    const float* SU = (const float*)(p.ws + OFF_PSC) + (size_t)(layer * 2) * NEXP;
    const float* SV = SU + NEXP;
    if (h == 0) {
        int* dst = (int*)(p.ws + OFF_EIDX) + (size_t)tok * 128;
        float* dsu = (float*)(p.ws + OFF_SUE) + (size_t)tok * 128 + head * 16;
#pragma unroll
        for (int q = 0; q < 8; ++q) { u32x2 pr = {(unsigned)ei[q], (unsigned)ei[q + 8]}; *(u32x2*)(dst + q * 16 + head * 2) = pr; }
#pragma unroll
        for (int q = 0; q < 4; ++q) { f32x4 u = {SU[ei[4 * q]], SU[ei[4 * q + 1]], SU[ei[4 * q + 2]], SU[ei[4 * q + 3]]}; *(f32x4*)(dsu + 4 * q) = u; }
    } else {
        float* dst = (float*)(p.ws + OFF_GATE) + (size_t)tok * 128 + head * 16;
#pragma unroll
        for (int q = 0; q < 4; ++q) { f32x4 v = {fs[4 * q] * inv * SV[ei[4 * q]], fs[4 * q + 1] * inv * SV[ei[4 * q + 1]], fs[4 * q + 2] * inv * SV[ei[4 * q + 2]], fs[4 * q + 3] * inv * SV[ei[4 * q + 3]]}; *(f32x4*)(dst + 4 * q) = v; }
    }
}
#undef P7_IDS
DI float gelu_exact(float v) { return 0.5f * v * (1.f + erff(v * 0.70710678118654752f)); }
constexpr int P8_TPW = 32;
constexpr int P8_GRABS = NTOK / (4 * P8_TPW);
constexpr size_t SLICE_BYTES = (size_t)NEXP * 128;

DI int p8_next(unsigned* ctr8, volatile int* slot, int& slice, int layer) {
    __syncthreads();
    if (threadIdx.x == 0) {
        int s = slice, g = -1;
        for (int tries = 0; tries < 8; ++tries) {
            const int v = (int)atomicAdd(&ctr8[s], 1u);
            if (v < (layer ? 256 : P8_GRABS)) { g = layer ? ((v >> 7) * 130 + 2 + (v & 127)) : v; break; }
            s = (s + 1) & 7;
        }
        slot[0] = g; slot[1] = s;
    }
    __syncthreads();
    slice = __builtin_amdgcn_readfirstlane(slot[1]);
    return __builtin_amdgcn_readfirstlane(slot[0]);
}

typedef int i32x4b __attribute__((ext_vector_type(4)));
#define P8_ISSUE_M(ur_, ev_, base_, m_)                                                                      \
    { _Pragma("unroll") for (int b = 0; b < 16; ++b) {                                                       \
          const int e_ = ev_[b >> 2][b & 3];                                                                 \
          ur_[b] = *(const u32x4*)((base_) + (unsigned)(((e_ & (m_)) << 7) + lo16_)); } }
#define P8_ISSUE(ur_, ev_, base_) P8_ISSUE_M(ur_, ev_, base_, 0x7fffffff)
#define P8_LOADE(ev_, n_) { const i32x4b* ep_ = (const i32x4b*)(EI + (size_t)(n_) * 128 + eg * 16); ev_[0] = ep_[0]; ev_[1] = ep_[1]; ev_[2] = ep_[2]; ev_[3] = ep_[3]; }
DI int dpp_x1(int v) { return __builtin_amdgcn_update_dpp(0, v, 0xB1, 0xF, 0xF, true); }
DI int dpp_x2(int v) { return __builtin_amdgcn_update_dpp(0, v, 0x4E, 0xF, 0xF, true); }
DI int dpp_x8(int v) { return __builtin_amdgcn_update_dpp(0, v, 0x128, 0xF, 0xF, true); }
DI int shxi(int v, int mask, int lane) { return __builtin_amdgcn_ds_bpermute((lane ^ mask) << 2, v); }

DI void p8a_compute(const u32x4 (&ur)[16], const u32x4& xq, bf16_t* dst, int lane, int eg) {
    int part[16];
#pragma unroll
    for (int b = 0; b < 16; ++b) {
        int acc = 0;
#pragma unroll
        for (int d = 0; d < 4; ++d) acc = __builtin_amdgcn_sdot4((int)ur[b][d], (int)xq[d], acc, false);
        part[b] = acc;
    }
    int v8[8], v4[4], v2[2];
    { const bool up = lane & 1;
#pragma unroll
      for (int q = 0; q < 8; ++q) { const int send = up ? part[q] : part[8 + q]; const int recv = dpp_x1(send); v8[q] = (up ? part[8 + q] : part[q]) + recv; } }
    { const bool up = lane & 2;
#pragma unroll
      for (int q = 0; q < 4; ++q) { const int send = up ? v8[q] : v8[4 + q]; const int recv = dpp_x2(send); v4[q] = (up ? v8[4 + q] : v8[q]) + recv; } }
    { const bool up = lane & 4;
#pragma unroll
      for (int q = 0; q < 2; ++q) { const int send = up ? v4[q] : v4[2 + q]; const int recv = shxi(send, 4, lane); v2[q] = (up ? v4[2 + q] : v4[q]) + recv; } }
    const int b0 = 8 * (lane & 1) + 4 * ((lane >> 1) & 1) + 2 * ((lane >> 2) & 1);
    dst[8 * b0 + eg] = f2bf((float)v2[0]);
    dst[8 * (b0 + 1) + eg] = f2bf((float)v2[1]);
}

DI void p8a_phase(const Params& p, int layer, unsigned* ctr8, volatile int* slot, bool rep = false) {
    const int emask = (PROBE_HOT && rep) ? 63 : 0x7fffffff;
    const int lane = ltid() & 63, w = ltid() >> 6, sub = lane & 7, eg = lane >> 3;
    int slice = (int)(xb_xcc_id() & 7u);
    const unsigned char* PU = (const unsigned char*)(p.ws + OFF_PU) + (size_t)layer * NEXP * D;
    bf16_t* PD = (bf16_t*)(p.ws + OFF_PD);
    const int* EI = (const int*)(p.ws + OFF_EIDX);
    for (;;) {
        const int g = p8_next(ctr8, slot, slice, layer);
        if (g < 0) break;
        const unsigned char* Us = PU + (size_t)slice * SLICE_BYTES;
        const unsigned lo16_ = 16u * sub;
        const int nb = (g * 4 + w) * P8_TPW;
        const unsigned char* xbase = (const unsigned char*)(p.ws + OFF_XQ) + slice * 128 + 16 * sub;
        bf16_t* pdb = PD + (size_t)slice * NTOK * 128;
        i32x4b eA[4], eB[4];
        P8_LOADE(eA, nb); P8_LOADE(eB, nb + 1);
        u32x4 urA[16], urB[16], xA, xB;
        P8_ISSUE_M(urA, eA, Us, emask);
        xA = *(const u32x4*)(xbase + (size_t)nb * D);
        { const int n2 = 2 < P8_TPW ? nb + 2 : nb; P8_LOADE(eA, n2); }
        for (int tt = 0; tt < P8_TPW; tt += 2) {
            const int n = nb + tt;
            P8_ISSUE_M(urB, eB, Us, emask);
            xB = *(const u32x4*)(xbase + (size_t)(n + 1) * D);
            { const int n3 = tt + 3 < P8_TPW ? n + 3 : n; P8_LOADE(eB, n3); }
            __builtin_amdgcn_sched_barrier(0);
            p8a_compute(urA, xA, pdb + (size_t)n * 128, lane, eg);
            __builtin_amdgcn_sched_barrier(0);
            if (tt + 2 < P8_TPW) {
                P8_ISSUE_M(urA, eA, Us, emask);
                xA = *(const u32x4*)(xbase + (size_t)(n + 2) * D);
                { const int n4 = tt + 4 < P8_TPW ? n + 4 : n; P8_LOADE(eA, n4); }
            }
            __builtin_amdgcn_sched_barrier(0);
            p8a_compute(urB, xB, pdb + (size_t)(n + 1) * 128, lane, eg);
            __builtin_amdgcn_sched_barrier(0);
        }
    }
}
DI void p8b_compute(const Params& p, const u32x4 (&vr)[16], const u32x4& wq, float sw, int n, float* xr, const f32x2& xv, const f32x2& gv, int lane, int col, bool rep = false) {
    int f[16];
#pragma unroll
    for (int e = 0; e < 16; ++e) f[e] = 0;
#pragma unroll
    for (int j = 0; j < 4; ++j)
#pragma unroll
        for (int d = 0; d < 4; ++d) {
            const unsigned r0 = vr[4 * j][d], r1 = vr[4 * j + 1][d], r2 = vr[4 * j + 2][d], r3 = vr[4 * j + 3][d];
            const unsigned t01l = __builtin_amdgcn_perm(r1, r0, 0x05010400u), t01h = __builtin_amdgcn_perm(r1, r0, 0x07030602u);
            const unsigned t23l = __builtin_amdgcn_perm(r3, r2, 0x05010400u), t23h = __builtin_amdgcn_perm(r3, r2, 0x07030602u);
            const unsigned c0 = __builtin_amdgcn_perm(t23l, t01l, 0x05040100u), c1 = __builtin_amdgcn_perm(t23l, t01l, 0x07060302u);
            const unsigned c2 = __builtin_amdgcn_perm(t23h, t01h, 0x05040100u), c3 = __builtin_amdgcn_perm(t23h, t01h, 0x07060302u);
            f[4 * d + 0] = __builtin_amdgcn_sdot4((int)c0, (int)wq[j], f[4 * d + 0], false);
            f[4 * d + 1] = __builtin_amdgcn_sdot4((int)c1, (int)wq[j], f[4 * d + 1], false);
            f[4 * d + 2] = __builtin_amdgcn_sdot4((int)c2, (int)wq[j], f[4 * d + 2], false);
            f[4 * d + 3] = __builtin_amdgcn_sdot4((int)c3, (int)wq[j], f[4 * d + 3], false);
        }
    int r8[8], r4[4], r2[2];
    { const bool up = lane & 8;
#pragma unroll
      for (int q = 0; q < 8; ++q) { const int send = up ? f[q] : f[8 + q]; const int recv = dpp_x8(send); r8[q] = (up ? f[8 + q] : f[q]) + recv; } }
    { const bool up = lane & 16;
#pragma unroll
      for (int q = 0; q < 4; ++q) { const int send = up ? r8[q] : r8[4 + q]; const int recv = shxi(send, 16, lane); r4[q] = (up ? r8[4 + q] : r8[q]) + recv; } }
    { const bool up = lane & 32;
#pragma unroll
      for (int q = 0; q < 2; ++q) { const int send = up ? r4[q] : r4[2 + q]; const int recv = shxi(send, 32, lane); r2[q] = (up ? r4[2 + q] : r4[q]) + recv; } }
    f32x2 o; o[0] = fmaf(gv[0] * sw, (float)r2[0], xv[0]); o[1] = fmaf(gv[1] * sw, (float)r2[1], xv[1]);
    if (rep) *(f32x2*)((float*)(p.ws + OFF_PROJ) + (size_t)n * D + col) = o; else *(f32x2*)xr = o;
}

DI void p8b_phase(const Params& p, int layer, unsigned* ctr8, volatile int* slot, bool rep = false) {
    const int lane = ltid() & 63, w = ltid() >> 6, sub = lane & 7, eg = lane >> 3;
    int slice = (int)(xb_xcc_id() & 7u);
    const unsigned char* PV = (const unsigned char*)(p.ws + OFF_PV) + (size_t)layer * NEXP * D;
    const int* EI = (const int*)(p.ws + OFF_EIDX);
    const unsigned char* WQ = (const unsigned char*)(p.ws + OFF_WQ8) + 16 * eg;
    const float* SW = (const float*)(p.ws + OFF_SW);
    for (;;) {
        const int g = p8_next(ctr8, slot, slice, layer);
        if (g < 0) break;
        const unsigned char* Vs = PV + (size_t)slice * SLICE_BYTES;
        const unsigned lo16_ = 16u * sub;
        const int nb = (g * 4 + w) * P8_TPW;
        i32x4b eA[4], eB[4];
        P8_LOADE(eA, nb); P8_LOADE(eB, nb + 1);
        u32x4 vrA[16], vrB[16], wA, wB; float sA, sB;
        const int col = slice * 128 + 16 * sub + 2 * (4 * ((lane >> 3) & 1) + 2 * ((lane >> 4) & 1) + ((lane >> 5) & 1));
        float* xrow = xcur_row(p, nb) + col;
        const f32x2 gv = *(const f32x2*)(mod_vec(p, layer, nb) + 5120 + col);
        f32x2 xA, xB;
        P8_ISSUE(vrA, eA, Vs);
        xA = *(const f32x2*)xrow;
        wA = *(const u32x4*)(WQ + (size_t)nb * 128); sA = SW[nb];
        { const int n2 = 2 < P8_TPW ? nb + 2 : nb; P8_LOADE(eA, n2); }
        for (int tt = 0; tt < P8_TPW; tt += 2) {
            const int n = nb + tt;
            P8_ISSUE(vrB, eB, Vs);
            xB = *(const f32x2*)(xrow + (size_t)(tt + 1) * D);
            wB = *(const u32x4*)(WQ + (size_t)(n + 1) * 128); sB = SW[n + 1];
            { const int n3 = tt + 3 < P8_TPW ? n + 3 : n; P8_LOADE(eB, n3); }
            __builtin_amdgcn_sched_barrier(0);
            p8b_compute(p, vrA, wA, sA, n, xrow + (size_t)tt * D, xA, gv, lane, col, rep);
            __builtin_amdgcn_sched_barrier(0);
            if (tt + 2 < P8_TPW) {
                P8_ISSUE(vrA, eA, Vs);
                xA = *(const f32x2*)(xrow + (size_t)(tt + 2) * D);
                wA = *(const u32x4*)(WQ + (size_t)(n + 2) * 128); sA = SW[n + 2];
                { const int n4 = tt + 4 < P8_TPW ? n + 4 : n; P8_LOADE(eA, n4); }
            }
            __builtin_amdgcn_sched_barrier(0);
            p8b_compute(p, vrB, wB, sB, n + 1, xrow + (size_t)(tt + 1) * D, xB, gv, lane, col, rep);
            __builtin_amdgcn_sched_barrier(0);
        }
    }
}

DI void p8w_phase(const Params& p) {
    const int lane = ltid() & 63;
    const int gw = blockIdx.x * 4 + (ltid() >> 6), nw = gridDim.x * 4;
    const bf16_t* PD = (const bf16_t*)(p.ws + OFF_PD);
    const float* G = (const float*)(p.ws + OFF_GATE);
    const float* S = (const float*)(p.ws + OFF_SUE);
    const float* SX = (const float*)(p.ws + OFF_SXQ);
    for (int n = gw; n < NTOK; n += 4 * nw) {
        int nn[4]; float dlo[4], dhi[4], sx[4], s0[4], s1[4], g0[4], g1[4];
#pragma unroll
        for (int t = 0; t < 4; ++t) { nn[t] = n + t * nw < NTOK ? n + t * nw : n; dlo[t] = 0.f; dhi[t] = 0.f; }
#pragma unroll
        for (int s = 0; s < 8; ++s)
#pragma unroll
            for (int t = 0; t < 4; ++t) { const bf16_t* pd = PD + ((size_t)s * NTOK + nn[t]) * 128; dlo[t] += bf2f(pd[lane]); dhi[t] += bf2f(pd[64 + lane]); }
#pragma unroll
        for (int t = 0; t < 4; ++t) { const size_t i = (size_t)nn[t] * 128 + lane; sx[t] = SX[nn[t]]; s0[t] = S[i]; s1[t] = S[i + 64]; g0[t] = G[i]; g1[t] = G[i + 64]; }
        __builtin_amdgcn_sched_barrier(0);
#pragma unroll
        for (int t = 0; t < 4; ++t) {
            if (n + t * nw >= NTOK) break;
            const float w_lo = gelu_exact(dlo[t] * (s0[t] * sx[t])) * g0[t], w_hi = gelu_exact(dhi[t] * (s1[t] * sx[t])) * g1[t];
            float am = fmaxf(fabsf(w_lo), fabsf(w_hi));
#pragma unroll
            for (int o = 32; o > 0; o >>= 1) am = fmaxf(am, shx(am, o, lane));
            const float sc = am > 0.f ? am * (1.f / 127.f) : 1.f, inv = 1.f / sc;
            unsigned char* wq = (unsigned char*)(p.ws + OFF_WQ8) + (size_t)nn[t] * 128;
            wq[(lane & 7) * 16 + (lane >> 3)] = (unsigned char)(__float2int_rn(w_lo * inv) & 255);
            wq[(lane & 7) * 16 + 8 + (lane >> 3)] = (unsigned char)(__float2int_rn(w_hi * inv) & 255);
            if (lane == 0) ((float*)(p.ws + OFF_SW))[nn[t]] = sc;
        }
    }
}

DI void final_norm_phase(const Params& p) {
    const int lane = ltid() & 63;
    const int gw = blockIdx.x * 4 + (ltid() >> 6), nw = gridDim.x * 4;
    for (int i = gw; i < NB * T; i += nw) {
        float* row = p.out + (size_t)i * D;
        f32x4 v[4]; load_row16(row, lane, v);
        const float rstd = row_rstd(v, lane);
#pragma unroll
        for (int q = 0; q < 4; ++q) {
            const int c = 4 * lane + 256 * q;
            const f32x4 gv = *(const f32x4*)(p.in[22] + c);
            f32x4 o;
#pragma unroll
            for (int e = 0; e < 4; ++e) o[e] = v[q][e] * rstd * gv[e];
            *(f32x4*)(row + c) = o;
        }
    }
}
constexpr int P3_MLA = NB * 4 * (T / 256);
constexpr int P3_NA = NB * 4 * (T / 128);
constexpr int P3_SWA = NB * 4 * (T / 128);
constexpr int P3_CTX = 3 * NB * 4 * 2;
constexpr int P3_TAB = TAB_ITEMS;
constexpr int P3_ATT = P3_SCAN + P3_MLA + P3_NA + P3_SWA + P3_CTX;
constexpr int P3_ITEMS = P3_ATT + P4_ITEMS;

DI void p3_item(const Params& p, int layer, int item, char* lds, bool rep = false) {
    unsigned* scan_done = (unsigned*)(p.ws + OFF_CTL) + 128 + layer;
    if (item < P3_SCAN) {
        p3_scan(p, item);
        asm volatile("s_waitcnt vmcnt(0)" ::: "memory");
        __syncthreads();
        if (threadIdx.x == 0) { __builtin_amdgcn_fence(__ATOMIC_RELEASE, "agent"); asm volatile("s_waitcnt vmcnt(0)" ::: "memory"); __hip_atomic_fetch_add(scan_done, 1u, __ATOMIC_RELAXED, __HIP_MEMORY_SCOPE_AGENT); }
        return;
    }
    if (item >= P3_ATT) {
        if (threadIdx.x == 0) {
            unsigned spins = 0;
            while (__hip_atomic_load(scan_done, __ATOMIC_RELAXED, __HIP_MEMORY_SCOPE_AGENT) < (unsigned)P3_SCAN && ++spins < (1u << 22)) __builtin_amdgcn_s_sleep(2);
            __builtin_amdgcn_fence(__ATOMIC_ACQUIRE, "agent");
            asm volatile("s_waitcnt vmcnt(0)" ::: "memory");
        }
        __syncthreads();
        p4_mlstm_out(p, layer, item - P3_ATT, lds);
        return;
    }
    item -= P3_SCAN;
    const bf16_t* proj = (const bf16_t*)(p.ws + OFF_PROJ);
    bf16_t* Y = (bf16_t*)(p.ws + OFF_ACT);
    AttnJob J;
    J.has_sink = 0; J.sink2 = 0.f; J.tq0 = 0; J.probe = 0;
    if (item < P3_MLA) {
        const int b = item >> 8, hh = (item >> 6) & 3, qb = item & 63;
        const int n0 = b * P + CTXL + qb * 256;
        MlaJob M;
        M.Q = (const unsigned char*)(p.ws + OFF_QM) + ((size_t)n0 * 4 + hh) * 128;
        M.K = (const unsigned char*)(p.ws + OFF_KM) + (size_t)(b * 4 + hh) * P * 128;
        M.V = (const unsigned char*)(p.ws + OFF_VTM) + (size_t)(b * 4 + hh) * 64 * P;
        M.O = Y + (size_t)n0 * D + 512 + hh * 64; M.ldo = D;
        M.nkeys = P;
        attn_mla_mx(M, lds);
        return;
    }
    item -= P3_MLA;
    if (item < P3_NA) {
        const int b = item >> 9, hh = (item >> 7) & 3, rp = item & 127;
        const int n0 = b * P + CTXL + rp * 128;
        J.Q = proj + (size_t)n0 * PJ + C_NAQ + hh * 64; J.ldq = PJ;
        J.K = proj + (size_t)(b * P) * PJ + C_NAK + hh * 64; J.ldk = PJ;
        J.V = proj + (size_t)(b * P) * PJ + C_NAV + hh * 64; J.ldv = PJ;
        J.O = Y + (size_t)n0 * D + hh * 64; J.ldo = D;
        int ra = 2 * rp - 4; ra = ra < 0 ? 0 : (ra > 248 ? 248 : ra);
        int rb = 2 * rp + 1 - 4; rb = rb < 0 ? 0 : (rb > 248 ? 248 : rb);
        J.r0b = 0; J.r0e = CTXL; J.r1b = CTXL + ra * 64; J.r1e = CTXL + (rb + 8) * 64;
        J.tq0 = rp * 128;
        J.scale2 = 0.125f * LOG2E;
        float* rpb = (float*)(lds + ATT_RPB);
        __syncthreads();
        for (int i = ltid(); i < 15 * 31; i += 256) rpb[i] = p.in[9][((size_t)layer * 4 + hh) * 465 + i] * LOG2E;
        attn_job<64, false, 1>(J, lds);
        return;
    }
    item -= P3_NA;
    if (item < P3_SWA) {
        const int b = item >> 9, qh = (item >> 7) & 3, blk = item & 127;
        const int n0 = b * P + CTXL + blk * 128;
        J.Q = proj + (size_t)n0 * PJ + C_SWQ + qh * 64; J.ldq = PJ;
        J.K = proj + (size_t)(b * P) * PJ + C_SWK + (qh >> 1) * 64; J.ldk = PJ;
        J.V = proj + (size_t)(b * P) * PJ + C_SWV + (qh >> 1) * 64; J.ldv = PJ;
        J.O = Y + (size_t)n0 * D + 768 + qh * 64; J.ldo = D;
        int lo = blk * 128 - 128; lo = lo < 0 ? 0 : lo;
        int hi = blk * 128 + 256; hi = hi > T ? T : hi;
        J.r0b = 0; J.r0e = CTXL; J.r1b = CTXL + lo; J.r1e = CTXL + hi;
        J.tq0 = blk * 128;
        J.scale2 = 0.125f * LOG2E;
        J.has_sink = 1; J.sink2 = p.in[16][layer * 4 + qh] * LOG2E;
        attn_job<64, false, 2>(J, lds);
        return;
    }
    item -= P3_SWA;
    {
        const int kind = item / 16, b = (item >> 3) & 1, hh = (item >> 1) & 3, half = item & 1;
        const int n0 = b * P + half * 128;
        J.r0b = 0; J.r0e = CTXL; J.r1b = 0; J.r1e = 0;
        if (kind == 1) {
            if (half) return;
            MlaJob M;
            M.Q = (const unsigned char*)(p.ws + OFF_QM) + ((size_t)n0 * 4 + hh) * 128;
            M.K = (const unsigned char*)(p.ws + OFF_KM) + (size_t)(b * 4 + hh) * P * 128;
            M.V = (const unsigned char*)(p.ws + OFF_VTM) + (size_t)(b * 4 + hh) * 64 * P;
            M.O = Y + (size_t)n0 * D + 512 + hh * 64; M.ldo = D;
            M.nkeys = CTXL;
            attn_mla_mx(M, lds);
        } else {
            const int cq = kind == 0 ? C_NAQ + hh * 64 : C_SWQ + hh * 64;
            const int ck = kind == 0 ? C_NAK + hh * 64 : C_SWK + (hh >> 1) * 64;
            const int cv = kind == 0 ? C_NAV + hh * 64 : C_SWV + (hh >> 1) * 64;
            J.Q = proj + (size_t)n0 * PJ + cq; J.ldq = PJ;
            J.K = proj + (size_t)(b * P) * PJ + ck; J.ldk = PJ;
            J.V = proj + (size_t)(b * P) * PJ + cv; J.ldv = PJ;
            J.O = Y + (size_t)n0 * D + (kind == 0 ? 0 : 768) + hh * 64; J.ldo = D;
            J.scale2 = 0.125f * LOG2E;
            if (kind == 2) { J.has_sink = 1; J.sink2 = p.in[16][layer * 4 + hh] * LOG2E; }
            attn_job<64, false, 0>(J, lds);
        }
    }
}

DI void p2_item(const Params& p, int layer, int item, char* lds) {
    if (item < P2_MQ) { p2_mla_q(p, layer, item, lds); return; }
    item -= P2_MQ;
    if (item < P2_MKV) { p2_mla_kv(p, layer, item, lds); return; }
    item -= P2_MKV;
    if (item < P2_ML) { p2_mlstm(p, layer, item, lds); return; }
    item -= P2_ML;
    p2_rope(p, item);
}

#define QUEUE_LOOP(ctrp_, nitems_, body_)                                                                                  \
    { int it_cur_ = next_item((ctrp_), q_slot);                                                                            \
      while (it_cur_ < (nitems_)) {                                                                                        \
          int it_pre_ = 0;                                                                                                 \
          if (threadIdx.x == 0) it_pre_ = (int)atomicAdd((ctrp_), 1u);                                                     \
          { const int it = it_cur_; body_; }                                                                               \
          __syncthreads();                                                                                                 \
          if (threadIdx.x == 0) *q_slot = it_pre_;                                                                         \
          __syncthreads();                                                                                                 \
          it_cur_ = *q_slot; } }
DI int xq_next(unsigned* ctr8, volatile int* slot, int& q, int nmt, int per_mt) {
    __syncthreads();
    if (threadIdx.x == 0) {
        int qq = q, g = -1;
        for (int tries = 0; tries < 8; ++tries) {
            const int lo = qq * nmt / 8, hi = (qq + 1) * nmt / 8;
            const int v = (int)atomicAdd(&ctr8[qq], 1u);
            if (v < (hi - lo) * per_mt) { g = (lo + v / per_mt) * per_mt + v % per_mt; break; }
            qq = (qq + 1) & 7;
        }
        slot[0] = g; slot[1] = qq;
    }
    __syncthreads();
    q = slot[1];
    return slot[0];
}

#ifndef REP_PHASE
#define REP_PHASE -1
#endif
DI void run_phase(const Params& p, int ph, bool rep, char* lds, volatile int* q_slot) {
    unsigned* ctr = (unsigned*)(p.ws + OFF_CTL) + (rep ? 32 : 0);
    if (ph == 0) {
        { const int n0 = P0_TOTAL - P0_ROWS;
          for (;;) { const int it = next_item(&ctr[0], q_slot); if (it >= n0 + 2 * TAB_ITEMS) break;
                     if (it < n0) phase0_item(p, it, lds); else table_item(p, (it - n0) / TAB_ITEMS, (it - n0) % TAB_ITEMS); } }
    } else if (ph == 1) {
        phase_norm(p, 0, 0, true);
        for (int it = blockIdx.x; it < 2 * Q8_LAYER; it += gridDim.x) q8_item(p, it, lds);
    } else {
        const int layer = (ph - 2) / 10; int sub = (ph - 2) % 10; if (sub >= 3) ++sub;
        if (sub == 0) {
            for (;;) { const int it = next_item(&ctr[ph], q_slot); if (it >= P1_ITEMS) break; p1_item(p, layer, it, lds, rep); }
        } else if (sub == 1) {
            for (;;) { const int it = next_item(&ctr[ph], q_slot); if (it >= P2_ITEMS) break; if (rep && it >= P2_ITEMS - P2_ROPE) continue;
                if (rep && PROBE_VARIANT == 10 && it >= P2_MQ) continue; if (rep && PROBE_VARIANT == 11 && (it < P2_MQ || it >= P2_MQ + P2_MKV)) continue; if (rep && PROBE_VARIANT == 12 && it < P2_MQ + P2_MKV) continue;
                p2_item(p, layer, it, lds); }
        } else if (sub == 2) {
            {
                unsigned* ctrB = (unsigned*)(p.ws + OFF_CTL) + 160 + layer + (rep ? 2 : 0);
                const unsigned slot0 = (unsigned)__builtin_amdgcn_readfirstlane((int)((unsigned)__builtin_amdgcn_s_getreg((3 << 11) | 4) & 1u));
                __syncthreads();
                if (threadIdx.x == 0) q_slot[1] = (int)slot0;
                __syncthreads();
                const int role = __builtin_amdgcn_readfirstlane(q_slot[1]);
#define P3_QUEUE_A for (;;) { const int it = next_item(&ctr[ph], q_slot); if (it >= P3_MLA) break; p3_item(p, layer, P3_SCAN + it, lds, rep); }
#define P3_QUEUE_B for (;;) { int it = next_item(ctrB, q_slot); if (it >= P3_ITEMS - P3_MLA) break; if (it >= P3_SCAN) it += P3_MLA; p3_item(p, layer, it, lds, rep); }
                if (role == 0) { P3_QUEUE_A; P3_QUEUE_B; } else { P3_QUEUE_B; P3_QUEUE_A; }
#undef P3_QUEUE_A
#undef P3_QUEUE_B
            }
        } else if (sub == 3) {
            for (;;) { const int it = next_item(&ctr[ph], q_slot); if (it >= P4_ITEMS) break; p4_mlstm_out(p, layer, it, lds); }
        } else if (sub == 4) {
            { const int nit = layer == 0 ? P5_ITEMS : 2048;
              for (;;) { int it = next_item(&ctr[ph], q_slot); if (it >= nit) break; if (layer) { const int lt = it >> 3; it = ((lt >> 7) * 130 + 2 + (lt & 127)) * 8 + (it & 7); } p5_item(p, layer, it, lds); } }
        } else if (sub == 5) {
            phase_norm(p, layer, 1, false);
        } else if (sub == 6) {
            { const int nit = layer == 0 ? P7_ITEMS : 2048;
              for (;;) { int it = next_item(&ctr[ph], q_slot); if (it >= nit) break; if (layer) { const int lt = it >> 3; it = ((lt >> 7) * 130 + 2 + (lt & 127)) * 8 + (it & 7); } p7_item(p, layer, it, lds); } }
        } else if (sub == 7) {
            p8a_phase(p, layer, (unsigned*)(p.ws + OFF_CTL) + 64 + (rep ? 32 : 0) + (layer * 2 + 0) * 8, q_slot, rep);
        } else if (sub == 8) {
            p8w_phase(p);
        } else if (sub == 9) {
            p8b_phase(p, layer, (unsigned*)(p.ws + OFF_CTL) + 64 + (rep ? 32 : 0) + (layer * 2 + 1) * 8, q_slot, rep);
        } else {
            if (layer == 0) phase_norm(p, 1, 0, false); else final_norm_phase(p);
        }
    }
}

#define XB_TMO      128
#define XB_XCNT(j)  (256  + 64 * (j))
#define XB_XSUB(j)  (1280 + 64 * (j))
#define XB_XGEN(j)  (2304 + 64 * (j))
#define XB_TOP      3328
#define XB_TOPGEN   3392
#define XCD_BAR_WORDS 3456
#define XB_SPIN_CAP (1u << 18)
#define LAS __attribute__((address_space(3)))
DI unsigned xb_ld(unsigned* p) { return __hip_atomic_load(p, __ATOMIC_RELAXED, __HIP_MEMORY_SCOPE_AGENT); }
DI unsigned xb_add(unsigned* p, unsigned v) { return __hip_atomic_fetch_add(p, v, __ATOMIC_RELAXED, __HIP_MEMORY_SCOPE_AGENT); }
#define XB_SPIN(cond, bar) do { unsigned _sp = 0; while (cond) { __builtin_amdgcn_s_sleep(1); \
    if ((++_sp & 255u) == 0u) { if (xb_ld(&(bar)[XB_TMO])) break; if (_sp > XB_SPIN_CAP) { atomicAdd(&(bar)[XB_TMO], 1u); break; } } } } while (0)
struct XcdBarrier { unsigned* bar; unsigned x; volatile LAS unsigned* st; };
DI XcdBarrier xcd_barrier_post(unsigned* bar, volatile LAS unsigned* st) {
    XcdBarrier b; b.bar = bar; b.x = xb_xcc_id(); b.st = st;
    if (threadIdx.x == 0) (void)xb_add(&bar[XB_XCNT(b.x)], 1u);
    return b;
}
DI void xcd_barrier_complete(unsigned* bar, unsigned x, unsigned& nloc, unsigned& nx) {
    const unsigned G = gridDim.x * gridDim.y * gridDim.z;
    unsigned sum, cnt, mine, sp = 0u;
    for (;;) {
        sum = 0u; cnt = 0u; mine = 0u;
#pragma unroll
        for (unsigned j = 0; j < 16; ++j) { const unsigned c = xb_ld(&bar[XB_XCNT(j)]); sum += c; cnt += (c > 0u) ? 1u : 0u; mine = (j == x) ? c : mine; }
        if (sum == G) break;
        __builtin_amdgcn_s_sleep(1);
        if ((++sp & 255u) == 0u) { if (xb_ld(&bar[XB_TMO])) break; if (sp > XB_SPIN_CAP) { atomicAdd(&bar[XB_TMO], 1u); break; } }
    }
    nloc = mine > 0u ? mine : 1u; nx = cnt > 0u ? cnt : 1u;
}
DI void xcd_barrier(const XcdBarrier& b) {
    asm volatile("s_waitcnt vmcnt(0)" ::: "memory");
    __syncthreads();
    if (threadIdx.x == 0) {
        unsigned* bar = b.bar;
        __builtin_amdgcn_s_waitcnt(0);
        unsigned nloc = b.st[0], nx = b.st[1];
        if (nloc == 0u) { xcd_barrier_complete(bar, b.x, nloc, nx); b.st[0] = nloc; b.st[1] = nx; }
        const unsigned old = xb_add(&bar[XB_XSUB(b.x)], 1u);
        const unsigned gen = old / nloc;
        if (old + 1u == (gen + 1u) * nloc) {
            __builtin_amdgcn_fence(__ATOMIC_RELEASE, "agent");
            asm volatile("s_waitcnt vmcnt(0)" ::: "memory");
            const unsigned og = xb_add(&bar[XB_TOP], 1u);
            const unsigned tg = og / nx;
            if (og + 1u == (tg + 1u) * nx) xb_add(&bar[XB_TOPGEN], 1u);
            else XB_SPIN(xb_ld(&bar[XB_TOPGEN]) == tg, bar);
            __builtin_amdgcn_fence(__ATOMIC_ACQUIRE, "agent");
            xb_add(&bar[XB_XGEN(b.x)], 1u);
            asm volatile("s_waitcnt vmcnt(0)" ::: "memory");
        } else {
            XB_SPIN(xb_ld(&bar[XB_XGEN(b.x)]) == gen, bar);
            __builtin_amdgcn_fence(__ATOMIC_ACQUIRE, "agent");
            asm volatile("s_waitcnt vmcnt(0)" ::: "memory");
        }
    }
    __syncthreads();
}

typedef const __attribute__((address_space(4))) char* kaptr_t;
__global__ void __launch_bounds__(256, 2) fwd_megakernel(Params p_unused) {
    extern __shared__ __attribute__((aligned(16))) char lds[];
    __shared__ __attribute__((aligned(16))) unsigned sm4[4];
    cg::grid_group grid = cg::this_grid();
    kaptr_t ka = (kaptr_t)__builtin_amdgcn_kernarg_segment_ptr();
    const int ph_lo = ((const Params*)ka)->ph_lo, ph_hi = ((const Params*)ka)->ph_hi;
    volatile int* q_slot = (volatile int*)&sm4[0];
    if (threadIdx.x < 4) sm4[threadIdx.x] = 0u;
    __syncthreads();
    const XcdBarrier xb = xcd_barrier_post((unsigned*)(((const Params*)ka)->ws + OFF_BAR), (volatile LAS unsigned*)&sm4[2]);
    for (int ph = ph_lo; ph < ph_hi; ++ph) {
        asm volatile("" : "+s"(ka));
        const Params& p = *(const Params*)ka;
        if (REP_PHASE >= 0 && ph == REP_PHASE) { run_phase(p, ph, true, lds, q_slot); xcd_barrier(xb); }
        run_phase(p, ph, false, lds, q_slot);
        if (ph + 1 < ph_hi) { if (ph_hi > 1000) grid.sync(); else xcd_barrier(xb); }
    }
}

extern "C" void kernel_launch(void* const* d_in, const int* in_sizes, int n_in, void* d_out, int out_size, void* d_ws, size_t ws_size, hipStream_t stream) {
    static int grid_blocks = 0;
    if (grid_blocks == 0) {
        if (n_in != 23 || ws_size < WS_END) { fprintf(stderr, "kernel_launch: unexpected n_in %d or ws_size %zu (need %zu)\n", n_in, ws_size, (size_t)WS_END); grid_blocks = -1; return; }
        int dev = 0, cus = 0, per_cu = 0;
        hipGetDevice(&dev);
        hipDeviceGetAttribute(&cus, hipDeviceAttributeMultiprocessorCount, dev);
        hipFuncSetAttribute((const void*)fwd_megakernel, hipFuncAttributeMaxDynamicSharedMemorySize, LDS_BYTES);
        hipOccupancyMaxActiveBlocksPerMultiprocessor(&per_cu, (const void*)fwd_megakernel, 256, LDS_BYTES);
        if (per_cu < 1) { fprintf(stderr, "kernel_launch: occupancy query returned %d\n", per_cu); grid_blocks = -1; return; }
        if (per_cu > 2) per_cu = 2;
        grid_blocks = cus * per_cu;
        fprintf(stderr, "kernel_launch: grid %d (%d CUs x %d)\n", grid_blocks, cus, per_cu);
    }
    if (grid_blocks < 0) return;
    hipMemsetAsync((char*)d_ws + OFF_CTL, 0, CTL_BYTES, stream);
    Params p{};
    for (int i = 0; i < 23; ++i) p.in[i] = (const float*)d_in[i];
    p.out = (float*)d_out; p.ws = (char*)d_ws; p.ph_lo = 0; p.ph_hi = NPHASE;
    void* args[] = {&p};
    hipError_t e = hipLaunchCooperativeKernel((const void*)fwd_megakernel, dim3(grid_blocks), dim3(256), args, LDS_BYTES, stream);
    if (e != hipSuccess) fprintf(stderr, "kernel_launch: cooperative launch failed: %s (grid %d)\n", hipGetErrorString(e), grid_blocks);
}
```
